# Optimizing an MI355X kernel written in HIP

```python
import jax, jax.numpy as jnp
from jax import lax
import numpy as np

D_MODEL = 4096
BATCH = 1
SEQ = 16384
DEPTH = 2
DEC_BATCH = 4
DEC_SEQ = 2048
PAST_LEN = 128

HEAD_DIM = 128
MIX_WIDTH = D_MODEL
H_A = MIX_WIDTH // 4 // HEAD_DIM
H_B = MIX_WIDTH // 2 // HEAD_DIM
HKV_B = H_B // 4
H_C = MIX_WIDTH // 4 // HEAD_DIM
DILATED_PATTERNS = ((128, 1), (512, 4), (2048, 16))
ROPE_THETA = 500000.0
ROPE_DIM = HEAD_DIM // 4
AXIAL_THETA = 10000.0
Q_BLOCK = 128
GRID_W = 64
NA_ROWS = 8
NA_COLS = 16
D_FF = -((-8 * D_MODEL) // (3 * 256)) * 256
DEEPNORM_ALPHA = (2.0 * DEPTH) ** 0.25
DEEPNORM_BETA = (8.0 * DEPTH) ** -0.25
LN_EPS = 1e-5
RMS_EPS = 1e-6
NEG_INF = -1e30
IN_SIZES = (H_A * HEAD_DIM, H_A * HEAD_DIM, H_A * HEAD_DIM,
            H_B * HEAD_DIM, HKV_B * HEAD_DIM, HKV_B * HEAD_DIM,
            H_C * HEAD_DIM, H_C * HEAD_DIM, H_C * HEAD_DIM)

kernel_name = 'hybrid_dilated_axial_neighbourhood_encoder'


def layer_norm(x, g, b):
    xf = x.astype(jnp.float32)
    mu = jnp.mean(xf, -1, keepdims=True)
    var = jnp.mean(jnp.square(xf - mu), -1, keepdims=True)
    return ((xf - mu) * lax.rsqrt(var + LN_EPS) * g.astype(jnp.float32) + b.astype(jnp.float32)).astype(x.dtype)


def rms_norm(x, g):
    xf = x.astype(jnp.float32)
    return (xf * lax.rsqrt(jnp.mean(jnp.square(xf), -1, keepdims=True) + RMS_EPS) * g.astype(jnp.float32)).astype(x.dtype)


def group_rms(o):
    b, s, h, dh = o.shape
    of = o.reshape(b, s, h * dh).astype(jnp.float32)
    return (of * lax.rsqrt(jnp.mean(jnp.square(of), -1, keepdims=True) + RMS_EPS)).astype(o.dtype)


def rope(x, pos, theta):
    d = x.shape[-1]
    half = d // 2
    inv = theta ** (-jnp.arange(half, dtype=jnp.float32) * 2.0 / d)
    ang = pos.astype(jnp.float32)[:, None] * inv[None, :]
    cos = jnp.cos(ang)[:, None, :].astype(x.dtype)
    sin = jnp.sin(ang)[:, None, :].astype(x.dtype)
    x1, x2 = x[..., :half], x[..., half:]
    return jnp.concatenate([x1 * cos - x2 * sin, x2 * cos + x1 * sin], -1)


def banded_attention(q, k, v, half):
    n, length, dh = q.shape
    blk = half
    nb = -(-length // blk)
    lp = nb * blk
    qb = jnp.pad(q, ((0, 0), (0, lp - length), (0, 0))).reshape(n, nb, blk, dh)

    def windows(a):
        ab = jnp.pad(a, ((0, 0), (blk, lp - length + blk), (0, 0))).reshape(n, nb + 2, blk, dh)
        return jnp.concatenate([ab[:, :-2], ab[:, 1:-1], ab[:, 2:]], axis=2)

    kw, vw = windows(k), windows(v)
    s = jnp.einsum('nbqd,nbkd->nbqk', qb, kw).astype(jnp.float32) * (dh ** -0.5)
    qpos = jnp.arange(nb)[:, None] * blk + jnp.arange(blk)[None, :]
    kpos = jnp.arange(nb)[:, None] * blk - blk + jnp.arange(3 * blk)[None, :]
    rel = kpos[:, None, :] - qpos[:, :, None]
    valid = (jnp.abs(rel) <= half) & (kpos[:, None, :] >= 0) & (kpos[:, None, :] < length)
    s = jnp.where(valid, s, NEG_INF)
    lse = jax.nn.logsumexp(s, -1)
    p = jnp.exp(s - lse[..., None]).astype(v.dtype)
    o = jnp.einsum('nbqk,nbkd->nbqd', p, vw)
    return o.reshape(n, lp, dh)[:, :length], lse.reshape(n, lp)[:, :length]


def dilated_attention(q, k, v):
    b, s, h, dh = q.shape
    t = jnp.arange(s)
    q = jnp.concatenate([rope(q[..., :ROPE_DIM], t, ROPE_THETA), q[..., ROPE_DIM:]], -1)
    k = jnp.concatenate([rope(k[..., :ROPE_DIM], t, ROPE_THETA), k[..., ROPE_DIM:]], -1)
    outs, lses = [], []
    for window, dil in DILATED_PATTERNS:
        n = s // dil
        qr = q.reshape(b, n, dil, h, dh).transpose(0, 2, 3, 1, 4).reshape(b * dil * h, n, dh)
        kr = k.reshape(b, n, dil, h, dh).transpose(0, 2, 3, 1, 4).reshape(b * dil * h, n, dh)
        vr = v.reshape(b, n, dil, h, dh).transpose(0, 2, 3, 1, 4).reshape(b * dil * h, n, dh)
        o, lse = banded_attention(qr, kr, vr, (window // 2) // dil)
        outs.append(o.reshape(b, dil, h, n, dh).transpose(0, 3, 1, 2, 4).reshape(b, s, h, dh))
        lses.append(lse.reshape(b, dil, h, n).transpose(0, 3, 1, 2).reshape(b, s, h))
    wts = jax.nn.softmax(jnp.stack(lses, -1), -1)
    return jnp.einsum('bshpd,bshp->bshd', jnp.stack(outs, 3), wts.astype(q.dtype))


def axial_gqa(q, k, v, g_q, g_k):
    b, s, h, dh = q.shape
    hkv = k.shape[2]
    grp = h // hkv
    t = jnp.arange(s)
    row, col = t // GRID_W, t % GRID_W
    half = dh // 2
    q = rms_norm(q, g_q)
    k = rms_norm(k, g_k)
    q = jnp.concatenate([rope(q[..., :half], row, AXIAL_THETA), rope(q[..., half:], col, AXIAL_THETA)], -1)
    k = jnp.concatenate([rope(k[..., :half], row, AXIAL_THETA), rope(k[..., half:], col, AXIAL_THETA)], -1)
    nblk = s // Q_BLOCK
    qb = q.reshape(b, nblk, Q_BLOCK, hkv, grp, dh).transpose(1, 0, 2, 3, 4, 5)
    scale = dh ** -0.5

    def block(qi):
        sc = jnp.einsum('bqkgd,bskd->bkgqs', qi, k).astype(jnp.float32) * scale
        p = jax.nn.softmax(sc, -1).astype(v.dtype)
        return jnp.einsum('bkgqs,bskd->bqkgd', p, v)

    o = lax.map(block, qb)
    return o.transpose(1, 0, 2, 3, 4, 5).reshape(b, s, h, dh)


def neighbourhood_attention(q, k, v, rpb):
    b, s, h, dh = q.shape
    rows = s // GRID_W
    kr = min(NA_ROWS, rows)
    kc = NA_COLS
    qg = q.reshape(b, rows, GRID_W, h, dh).transpose(0, 3, 1, 2, 4)
    kg = k.reshape(b, rows, GRID_W, h, dh).transpose(0, 3, 1, 2, 4)
    vg = v.reshape(b, rows, GRID_W, h, dh).transpose(0, 3, 1, 2, 4)
    r = jnp.arange(rows)
    c = jnp.arange(GRID_W)
    rstart = jnp.clip(r - kr // 2, 0, rows - kr)
    ridx = rstart[:, None] + jnp.arange(kr)[None, :]
    kn, vn = kg[:, :, ridx], vg[:, :, ridx]
    sc = jnp.einsum('bhiqd,bhirkd->bhiqrk', qg, kn).astype(jnp.float32) * (dh ** -0.5)
    roff = ridx - r[:, None] + (NA_ROWS - 1)
    coff = jnp.clip(c[None, :] - c[:, None], -(kc - 1), kc - 1) + (kc - 1)
    bias = rpb[:, roff[:, None, :, None], coff[None, :, None, :]]
    cstart = jnp.clip(c - kc // 2, 0, GRID_W - kc)
    cmask = (c[None, :] >= cstart[:, None]) & (c[None, :] < cstart[:, None] + kc)
    sc = jnp.where(cmask[:, None, :], sc + bias.astype(jnp.float32), NEG_INF)
    p = jax.nn.softmax(sc.reshape(b, h, rows, GRID_W, kr * GRID_W), -1).reshape(sc.shape).astype(v.dtype)
    o = jnp.einsum('bhiqrk,bhirkd->bhiqd', p, vn)
    return o.transpose(0, 2, 3, 1, 4).reshape(b, s, h, dh)


def encoder_layer(x, w_in, g_qn, g_kn, rpb, g_grp, w_out, ln1_g, ln1_b, w_gate, w_up, w_down, ln2_g, ln2_b):
    b, s, _ = x.shape
    proj = jnp.einsum('bsd,de->bse', x, w_in)
    offsets = np.cumsum(IN_SIZES)[:-1].tolist()
    qa, ka, va, qb, kb, vb, qc, kc, vc = jnp.split(proj, offsets, axis=-1)
    oa = dilated_attention(qa.reshape(b, s, H_A, HEAD_DIM), ka.reshape(b, s, H_A, HEAD_DIM),
                           va.reshape(b, s, H_A, HEAD_DIM))
    ob = axial_gqa(qb.reshape(b, s, H_B, HEAD_DIM), kb.reshape(b, s, HKV_B, HEAD_DIM),
                   vb.reshape(b, s, HKV_B, HEAD_DIM), g_qn, g_kn)
    oc = neighbourhood_attention(qc.reshape(b, s, H_C, HEAD_DIM), kc.reshape(b, s, H_C, HEAD_DIM),
                                 vc.reshape(b, s, H_C, HEAD_DIM), rpb)
    mixed = jnp.concatenate([group_rms(oa), group_rms(ob), group_rms(oc)], -1) * g_grp
    x = layer_norm(DEEPNORM_ALPHA * x + jnp.einsum('bse,ed->bsd', mixed, w_out), ln1_g, ln1_b)
    hdn = jax.nn.silu(jnp.einsum('bsd,df->bsf', x, w_gate)) * jnp.einsum('bsd,df->bsf', x, w_up)
    x = layer_norm(DEEPNORM_ALPHA * x + jnp.einsum('bsf,fd->bsd', hdn, w_down), ln2_g, ln2_b)
    return x


def setup_inputs(seed: int = 0) -> dict:
    key = jax.random.key(seed)
    ks = jax.random.split(key, 16)

    def nrm(k, shape, scale):
        return jax.random.normal(k, shape, jnp.float32) * scale

    in_width = sum(IN_SIZES)
    return {
        'x_prompt': nrm(ks[0], (BATCH, SEQ, D_MODEL), 1.0),
        'x_sample': nrm(ks[1], (DEC_BATCH, DEC_SEQ, D_MODEL), 1.0),
        'w_in': nrm(ks[2], (DEPTH, D_MODEL, in_width), D_MODEL ** -0.5),
        'g_qn': 1.0 + nrm(ks[3], (DEPTH, HEAD_DIM), 0.02),
        'g_kn': 1.0 + nrm(ks[4], (DEPTH, HEAD_DIM), 0.02),
        'rpb': nrm(ks[5], (DEPTH, H_C, 2 * NA_ROWS - 1, 2 * NA_COLS - 1), 0.02),
        'g_grp': 1.0 + nrm(ks[6], (DEPTH, MIX_WIDTH), 0.02),
        'w_out': nrm(ks[7], (DEPTH, MIX_WIDTH, D_MODEL), MIX_WIDTH ** -0.5 * DEEPNORM_BETA),
        'ln1_g': 1.0 + nrm(ks[8], (DEPTH, D_MODEL), 0.02),
        'ln1_b': nrm(ks[9], (DEPTH, D_MODEL), 0.02),
        'w_gate': nrm(ks[10], (DEPTH, D_MODEL, D_FF), D_MODEL ** -0.5),
        'w_up': nrm(ks[11], (DEPTH, D_MODEL, D_FF), D_MODEL ** -0.5),
        'w_down': nrm(ks[12], (DEPTH, D_FF, D_MODEL), D_FF ** -0.5 * DEEPNORM_BETA),
        'ln2_g': 1.0 + nrm(ks[13], (DEPTH, D_MODEL), 0.02),
        'ln2_b': nrm(ks[14], (DEPTH, D_MODEL), 0.02),
    }


def reference(x_prompt, x_sample, w_in, g_qn, g_kn, rpb, g_grp, w_out, ln1_g, ln1_b, w_gate, w_up, w_down, ln2_g, ln2_b):
    def trunk(x):
        for l in range(DEPTH):
            x = encoder_layer(x, w_in[l], g_qn[l], g_kn[l], rpb[l], g_grp[l], w_out[l],
                              ln1_g[l], ln1_b[l], w_gate[l], w_up[l], w_down[l], ln2_g[l], ln2_b[l])
        return x

    y_prompt = trunk(x_prompt)
    y_sample = trunk(x_sample)
    return (y_prompt, y_sample)
```

```cpp
#include <hip/hip_runtime.h>
#include <cstdio>
#include <cstdint>
#define XB_TMO      128
#define XB_XCNT(j)  (256  + 64 * (j))
#define XB_XSUB(j)  (1280 + 64 * (j))
#define XB_XGEN(j)  (2304 + 64 * (j))
#define XB_TOP      3328
#define XB_TOPGEN   3392
#define XCD_BAR_WORDS 3456
#define XB_SPIN_CAP (1u << 18)
#define LAS __attribute__((address_space(3)))

__device__ __forceinline__ unsigned xb_ld(unsigned* p)              { return __hip_atomic_load(p, __ATOMIC_RELAXED, __HIP_MEMORY_SCOPE_AGENT); }
__device__ __forceinline__ unsigned xb_add(unsigned* p, unsigned v) { return __hip_atomic_fetch_add(p, v, __ATOMIC_RELAXED, __HIP_MEMORY_SCOPE_AGENT); }
__device__ __forceinline__ unsigned xb_xcc_id() { return (unsigned)__builtin_amdgcn_s_getreg((3 << 11) | 20) & 0xFu; }
#define XB_SPIN(cond, bar) do { unsigned _sp = 0; while (cond) { __builtin_amdgcn_s_sleep(1); \
    if ((++_sp & 255u) == 0u) { if (xb_ld(&(bar)[XB_TMO])) break; if (_sp > XB_SPIN_CAP) { atomicAdd(&(bar)[XB_TMO], 1u); break; } } } } while (0)

struct XcdBarrier {
    unsigned* bar; unsigned x;
    volatile LAS unsigned* st;
};

__device__ __forceinline__ XcdBarrier xcd_barrier_post(unsigned* bar, volatile LAS unsigned* st) {
    XcdBarrier b; b.bar = bar; b.x = xb_xcc_id(); b.st = st;
    if (threadIdx.x == 0) (void)xb_add(&bar[XB_XCNT(b.x)], 1u);
    return b;
}
__device__ __forceinline__ void xcd_barrier_complete(unsigned* bar, unsigned x, unsigned& nloc, unsigned& nx) {
    const unsigned G = gridDim.x * gridDim.y * gridDim.z;
    unsigned sum, cnt, mine, sp = 0u;
    for (;;) {
        sum = 0u; cnt = 0u; mine = 0u;
#pragma unroll
        for (unsigned j = 0; j < 16; ++j) { const unsigned c = xb_ld(&bar[XB_XCNT(j)]); sum += c; cnt += (c > 0u) ? 1u : 0u; mine = (j == x) ? c : mine; }
        if (sum == G) break;
        __builtin_amdgcn_s_sleep(1);
        if ((++sp & 255u) == 0u) { if (xb_ld(&bar[XB_TMO])) break; if (sp > XB_SPIN_CAP) { atomicAdd(&bar[XB_TMO], 1u); break; } }
    }
    nloc = mine > 0u ? mine : 1u; nx = cnt > 0u ? cnt : 1u;
}

__device__ __forceinline__ void xcd_barrier(const XcdBarrier& b) {
    asm volatile("s_waitcnt vmcnt(0)" ::: "memory");
    __syncthreads();
    if (threadIdx.x == 0) {
        unsigned* bar = b.bar;
        __builtin_amdgcn_s_waitcnt(0);
        unsigned nloc = b.st[0], nx = b.st[1];
        if (nloc == 0u) { xcd_barrier_complete(bar, b.x, nloc, nx); b.st[0] = nloc; b.st[1] = nx; }
        const unsigned old = xb_add(&bar[XB_XSUB(b.x)], 1u);
        const unsigned gen = old / nloc;
        if (old + 1u == (gen + 1u) * nloc) {
            __builtin_amdgcn_fence(__ATOMIC_RELEASE, "agent");
            asm volatile("s_waitcnt vmcnt(0)" ::: "memory");
            const unsigned og = xb_add(&bar[XB_TOP], 1u);
            const unsigned tg = og / nx;
            if (og + 1u == (tg + 1u) * nx) xb_add(&bar[XB_TOPGEN], 1u);
            else XB_SPIN(xb_ld(&bar[XB_TOPGEN]) == tg, bar);
            __builtin_amdgcn_fence(__ATOMIC_ACQUIRE, "agent");
            xb_add(&bar[XB_XGEN(b.x)], 1u);
            asm volatile("s_waitcnt vmcnt(0)" ::: "memory");
        } else {
            XB_SPIN(xb_ld(&bar[XB_XGEN(b.x)]) == gen, bar);
            __builtin_amdgcn_fence(__ATOMIC_ACQUIRE, "agent");
            asm volatile("s_waitcnt vmcnt(0)" ::: "memory");
        }
    }
    __syncthreads();
}
namespace pg8 {
__device__ __forceinline__ int otid() { int t = (int)threadIdx.x; asm volatile("" : "+v"(t)); return t; }
__device__ __forceinline__ int obid() { int b = (int)blockIdx.x; asm volatile("" : "+s"(b)); return b; }

#define PG8_LAS __attribute__((address_space(3)))
typedef unsigned short bf16_t;
typedef short bf16x8 __attribute__((ext_vector_type(8)));
typedef float f32x4 __attribute__((ext_vector_type(4)));
typedef unsigned u32x4 __attribute__((ext_vector_type(4)));
constexpr int BM = 256, BK = 64, HALF = 128, HTB = HALF * BK * 2  , STAGE_BYTES = 8 * HTB, NXCD = 8, WGM = 8;

__host__ __device__ __forceinline__ int lds_byte(int r, int c) { const int st = (r >> 4) * 2 + (c >> 5), rr = r & 15, cc = c & 31, ob = rr * 64 + cc * 2; return st * 1024 + (ob ^ (((ob >> 9) & 1) << 5)); }
__host__ __device__ __forceinline__ void stage_rc(int b, int& R, int& C) { const int st = b / 1024, sb = b % 1024, swz = sb ^ (((sb >> 9) & 1) << 5); R = (st >> 1) * 16 + swz / 64; C = (st & 1) * 32 + (swz % 64) / 2; }
__host__ __device__ __forceinline__ int perm32(int rho) { const int n = rho >> 4, i = rho & 15; return 8 * (i >> 2) + 4 * n + (i & 3); }

struct Unit { int pm, pn; };
struct Gemm { const bf16_t* A; const bf16_t* Bt; int M, N, K; };

struct StaticOrder {
    int nM, nN, nwg, G, c;
    __host__ __device__ void init(int M, int N, int G_, int c_) { nM = M / BM; nN = N / BM; nwg = nM * nN; G = G_; c = c_; }
    __host__ __device__ bool next(int i, Unit& u) const {
        const long L = (long)i * G + c; if (L >= nwg) return false;
        int wgid = (int)L; { const int q = nwg / NXCD, r = nwg % NXCD, xcd = wgid % NXCD, off = wgid / NXCD; wgid = (xcd < r ? xcd * (q + 1) : r * (q + 1) + (xcd - r) * q) + off; }
        const int nig = WGM * nN, gid = wgid / nig, fm = gid * WGM, gsz = (nM - fm) < WGM ? (nM - fm) : WGM;
        u.pm = fm + ((wgid % nig) % gsz); u.pn = (wgid % nig) / gsz; return true;
    }
    __device__ __forceinline__ void a_ready(const Unit&) const {}
    __device__ __forceinline__ void done(const Unit&) const {}
};
struct CountedOrder : StaticOrder {
    const unsigned* ready; unsigned need; unsigned* tmo;
    __device__ __forceinline__ void a_ready(const Unit& u) const {
        if (threadIdx.x < 64) {
            const unsigned long long t0 = __builtin_amdgcn_s_memrealtime(); unsigned polls = 0;
            while ((unsigned)__builtin_amdgcn_readfirstlane(__hip_atomic_load(ready + 64 * u.pm, __ATOMIC_RELAXED, __HIP_MEMORY_SCOPE_AGENT)) < need) {
                if ((++polls & 255u) == 0u && __builtin_amdgcn_readfirstlane(__hip_atomic_load(tmo, __ATOMIC_RELAXED, __HIP_MEMORY_SCOPE_AGENT)) != 0u) break;
                if (__builtin_amdgcn_s_memrealtime() - t0 > 2000000ull) {
                    if (threadIdx.x == 0) { unsigned expect = 0u; __hip_atomic_compare_exchange_strong(tmo + 1, &expect, 0x600u | (unsigned)(u.pm & 0xff), __ATOMIC_RELAXED, __ATOMIC_RELAXED, __HIP_MEMORY_SCOPE_AGENT); __hip_atomic_store(tmo, 1u, __ATOMIC_RELAXED, __HIP_MEMORY_SCOPE_AGENT); }
                    break; }
                __builtin_amdgcn_s_sleep(2); }
            __builtin_amdgcn_fence(__ATOMIC_ACQUIRE, "agent");
            asm volatile("s_waitcnt vmcnt(0)" ::: "memory");
        }
#if !defined(BROKEN_HOOK_NO_BARRIER)
        asm volatile("" ::: "memory"); __builtin_amdgcn_s_barrier(); asm volatile("" ::: "memory");
#endif
    }
};

__device__ __forceinline__ unsigned cvt_pk_bf16(float lo, float hi) { unsigned r; asm volatile("v_cvt_pk_bf16_f32 %0, %1, %2" : "=v"(r) : "v"(lo), "v"(hi)); return r; }
typedef float f32x2 __attribute__((ext_vector_type(2)));
__device__ __forceinline__ f32x2 gelu_pk(f32x2 v) {
    const f32x2 av = __builtin_elementwise_abs(v), d = av * 0.2316418882f + 1.0f;
    f32x2 t; t.x = __builtin_amdgcn_rcpf(d.x); t.y = __builtin_amdgcn_rcpf(d.y);
    f32x2 q = t * 0.5307027145f + (-0.7265760135f); q = q * t + 0.7107068705f; q = q * t + (-0.142248368f); q = q * t + 0.127414796f; q = q * t;
    const f32x2 s = (v * v) * (-0.72134752044f);
    f32x2 e; e.x = __builtin_amdgcn_exp2f(s.x); e.y = __builtin_amdgcn_exp2f(s.y);
    const f32x2 m = v * (q * e), r = v - m;
    f32x2 o; o.x = v.x < 0.f ? m.x : r.x; o.y = v.y < 0.f ? m.y : r.y; return o;
}

struct EpiF32 {
    static constexpr bool PERM = false, AFTER_DRAIN = false;
    float* C; int ldc; const float* bias;
    __device__ __forceinline__ void operator()(const f32x4 (&acc)[2][2][4][2], const Unit& u, int wr, int wc, int fr, int fq) const {
        const int row0 = u.pm * BM + wr * 64 + fr, col0 = u.pn * BM + wc * 32 + 4 * fq;
        f32x4 bv[2][2];
#pragma unroll
        for (int bj = 0; bj < 2; ++bj)
#pragma unroll
            for (int n = 0; n < 2; ++n) bv[bj][n] = bias ? *(const f32x4*)(bias + col0 + bj * HALF + n * 16) : (f32x4){0.f, 0.f, 0.f, 0.f};
#pragma unroll
        for (int ai = 0; ai < 2; ++ai)
#pragma unroll
            for (int m = 0; m < 4; ++m) { float* rowp = C + (size_t)(row0 + ai * HALF + m * 16) * ldc + col0;
#pragma unroll
                for (int bj = 0; bj < 2; ++bj)
#pragma unroll
                    for (int n = 0; n < 2; ++n) *(f32x4*)(rowp + bj * HALF + n * 16) = acc[ai][bj][m][n] + bv[bj][n]; }
    }
};
template <int ACT  > struct EpiBf16 {
    static constexpr bool PERM = true, AFTER_DRAIN = false;
    bf16_t* O; int ldc; const float* bias; int split_cols; size_t split_stride;
    __device__ __forceinline__ void operator()(const f32x4 (&acc)[2][2][4][2], const Unit& u, int wr, int wc, int fr, int fq) const {
        const int row0 = u.pm * BM + wr * 64 + fr; int colt = u.pn * BM; bf16_t* base = O;
        if (split_cols) { const int t = colt / split_cols; base += (size_t)t * split_stride; colt -= t * split_cols; }
        const int col0 = colt + wc * 32 + 8 * fq, bcol0 = u.pn * BM + wc * 32 + 8 * fq;
        f32x4 bv[2][2];
#pragma unroll
        for (int bj = 0; bj < 2; ++bj)
#pragma unroll
            for (int n = 0; n < 2; ++n) bv[bj][n] = bias ? *(const f32x4*)(bias + bcol0 + bj * HALF + 4 * n) : (f32x4){0.f, 0.f, 0.f, 0.f};
#pragma unroll
        for (int ai = 0; ai < 2; ++ai)
#pragma unroll
            for (int m = 0; m < 4; ++m) { bf16_t* rowp = base + (size_t)(row0 + ai * HALF + m * 16) * ldc + col0;
#pragma unroll
                for (int bj = 0; bj < 2; ++bj) { f32x4 v0 = acc[ai][bj][m][0] + bv[bj][0], v1 = acc[ai][bj][m][1] + bv[bj][1];
                    if (ACT == 1) { f32x2 a = gelu_pk((f32x2){v0[0], v0[1]}), b = gelu_pk((f32x2){v0[2], v0[3]}), c = gelu_pk((f32x2){v1[0], v1[1]}), d = gelu_pk((f32x2){v1[2], v1[3]});
                        v0 = (f32x4){a.x, a.y, b.x, b.y}; v1 = (f32x4){c.x, c.y, d.x, d.y}; }
                    if (ACT == 2) {
#pragma unroll
                        for (int j = 0; j < 4; ++j) { v0[j] = 0.5f * v0[j] * (1.0f + erff(v0[j] * 0.70710678f)); v1[j] = 0.5f * v1[j] * (1.0f + erff(v1[j] * 0.70710678f)); } }
                    u32x4 w; w.x = cvt_pk_bf16(v0[0], v0[1]); w.y = cvt_pk_bf16(v0[2], v0[3]); w.z = cvt_pk_bf16(v1[0], v1[1]); w.w = cvt_pk_bf16(v1[2], v1[3]);
                    *(u32x4*)(rowp + bj * HALF) = w; } }
    }
};
template <class Epi, class Sched, bool STAMP = false>
__device__ __forceinline__ void gemm_phase(PG8_LAS unsigned char* lds, const Gemm g, const Sched& S, const Epi& E, unsigned long long* stamps) {
    const int tid = otid(), wid = __builtin_amdgcn_readfirstlane(tid >> 6), lane = tid & 63, wr = wid >> 2, wc = wid & 3, fr = lane & 15, fq = lane >> 4;
    const int K = g.K, nt = K / BK;
    int ts_lo = 0, ts_hi = 0, nts = 0; const unsigned long long rt_entry = STAMP ? (unsigned long long)wall_clock64() : 0ull;
#define PG8_STAMP() do { if (STAMP && wid == 0 && nts < 64) { const unsigned long long _c = (unsigned long long)clock64(); \
        ts_lo = (lane == nts) ? (int)(unsigned)_c : ts_lo; ts_hi = (lane == nts) ? (int)(unsigned)(_c >> 32) : ts_hi; ++nts; } } while (0)
    PG8_STAMP();
    unsigned voffA[2], voffB[2];
#pragma unroll
    for (int i = 0; i < 2; ++i) { int R, C; stage_rc(tid * 16 + i * 8192, R, C); const int Rb = Epi::PERM ? ((R & ~31) + perm32(R & 31)) : R;
        voffA[i] = (unsigned)(R * K + C) * 2u; voffB[i] = (unsigned)(Rb * K + C) * 2u; }
    const size_t kstep = (size_t)(BK * 2);
    const size_t hstep = (size_t)HALF * K * 2;
    const size_t tstep = 2 * hstep;
    const unsigned ldsw = (unsigned)wid * 1024u;
    const int aoff = lds_byte(wr * 64 + fr, fq * 8), boff = lds_byte(wc * 32 + fr, fq * 8);
#define PG8_SA(b, h) (((b) * 2 + (h)) * HTB)
#define PG8_SB(b, h) ((4 + (b) * 2 + (h)) * HTB)
#define PG8_STAGE(bufoff, gbase, voff) do { _Pragma("unroll") for (int _i = 0; _i < 2; ++_i) \
        __builtin_amdgcn_global_load_lds((const unsigned*)((const char*)(gbase) + (voff)[_i]), (PG8_LAS unsigned*)(lds + (bufoff) + ldsw + _i * 8192), 16, 0, 0); } while (0)
#define PG8_LDA(dst, b, h) do { _Pragma("unroll") for (int m = 0; m < 4; ++m) _Pragma("unroll") for (int k = 0; k < 2; ++k) dst[m][k] = *(const PG8_LAS bf16x8*)(lds + PG8_SA(b, h) + aoff + m * 2048 + k * 1024); } while (0)
#define PG8_LDB(dst, b, h) do { _Pragma("unroll") for (int n = 0; n < 2; ++n) _Pragma("unroll") for (int k = 0; k < 2; ++k) dst[n][k] = *(const PG8_LAS bf16x8*)(lds + PG8_SB(b, h) + boff + n * 2048 + k * 1024); } while (0)
#define PG8_MMA(ai, bj, At, Bt) do { __builtin_amdgcn_s_setprio(1); _Pragma("unroll") for (int m = 0; m < 4; ++m) _Pragma("unroll") for (int n = 0; n < 2; ++n) _Pragma("unroll") for (int k = 0; k < 2; ++k) \
        acc[ai][bj][m][n] = __builtin_amdgcn_mfma_f32_16x16x32_bf16(Bt[n][k], At[m][k], acc[ai][bj][m][n], 0, 0, 0); __builtin_amdgcn_s_setprio(0); } while (0)
#define PG8_WAIT_V(n) asm volatile("s_waitcnt vmcnt(" #n ")" ::: "memory")
#define PG8_WAIT_L(n) asm volatile("s_waitcnt lgkmcnt(" #n ")" ::: "memory")
#define PG8_BAR __builtin_amdgcn_s_barrier()
#define PG8_SCHED __builtin_amdgcn_sched_barrier(0)
    Unit cur, nxt; int ui = 0;
    if (!S.next(0, cur)) return;
    f32x4 acc[2][2][4][2];
#pragma unroll
    for (int a = 0; a < 2; ++a)
#pragma unroll
        for (int b = 0; b < 2; ++b)
#pragma unroll
            for (int m = 0; m < 4; ++m)
#pragma unroll
                for (int n = 0; n < 2; ++n) acc[a][b][m][n] = (f32x4){0.f, 0.f, 0.f, 0.f};
    bf16x8 At[4][2], B0[2][2], B1[2][2];
    const char* cA = (const char*)g.A + (size_t)cur.pm * tstep; const char* cB = (const char*)g.Bt + (size_t)cur.pn * tstep;
    S.a_ready(cur);
    PG8_STAGE(PG8_SB(0, 0), cB, voffB); PG8_STAGE(PG8_SA(0, 0), cA, voffA); PG8_STAGE(PG8_SB(0, 1), cB + hstep, voffB); PG8_STAGE(PG8_SA(0, 1), cA + hstep, voffA);
    if (wr == 1) PG8_BAR;
    PG8_WAIT_V(4); PG8_BAR;
    PG8_STAGE(PG8_SB(1, 0), cB + kstep, voffB); PG8_STAGE(PG8_SA(1, 0), cA + kstep, voffA); PG8_STAGE(PG8_SB(1, 1), cB + hstep + kstep, voffB);
    PG8_WAIT_V(6); PG8_BAR;
    PG8_STAMP();
    for (;;) {
        const bool has_next = S.next(ui + 1, nxt);
        const char* nA = has_next ? (const char*)g.A + (size_t)nxt.pm * tstep : cA; const char* nB = has_next ? (const char*)g.Bt + (size_t)nxt.pn * tstep : cB;
        for (int t = 0; t < nt; t += 2) {
            const bool last = (t == nt - 2);
            const char* a1 = cA + (size_t)(t + 1) * kstep;
            const char* a2 = last ? nA : cA + (size_t)(t + 2) * kstep; const char* b2 = last ? nB : cB + (size_t)(t + 2) * kstep;
            const char* a3 = a2 + kstep; const char* b3 = b2 + kstep;
            if (last && has_next) S.a_ready(nxt);
            PG8_LDB(B0, 0, 0); PG8_SCHED; PG8_LDA(At, 0, 0); PG8_STAGE(PG8_SA(1, 1), a1 + hstep, voffA);
            PG8_WAIT_L(8); PG8_BAR; PG8_WAIT_L(0); PG8_MMA(0, 0, At, B0); PG8_BAR; PG8_SCHED;
            PG8_LDB(B1, 0, 1); PG8_STAGE(PG8_SB(0, 0), b2, voffB);
            PG8_BAR; PG8_WAIT_L(0); PG8_MMA(0, 1, At, B1); PG8_BAR;
            PG8_LDA(At, 0, 1); PG8_STAGE(PG8_SA(0, 0), a2, voffA);
            PG8_BAR; PG8_WAIT_L(0); PG8_MMA(1, 0, At, B0); PG8_BAR; PG8_SCHED;
            PG8_STAGE(PG8_SB(0, 1), b2 + hstep, voffB);
            PG8_WAIT_V(6); PG8_BAR; PG8_MMA(1, 1, At, B1); PG8_BAR;
            PG8_LDB(B0, 1, 0); PG8_SCHED; PG8_LDA(At, 1, 0); PG8_STAGE(PG8_SA(0, 1), a2 + hstep, voffA);
            PG8_WAIT_L(8); PG8_BAR; PG8_WAIT_L(0); PG8_MMA(0, 0, At, B0); PG8_BAR; PG8_SCHED;
            PG8_LDB(B1, 1, 1); PG8_STAGE(PG8_SB(1, 0), b3, voffB);
            PG8_BAR; PG8_WAIT_L(0); PG8_MMA(0, 1, At, B1); PG8_BAR;
            PG8_LDA(At, 1, 1); PG8_STAGE(PG8_SA(1, 0), a3, voffA);
            PG8_BAR; PG8_WAIT_L(0); PG8_MMA(1, 0, At, B0); PG8_BAR; PG8_SCHED;
            PG8_STAGE(PG8_SB(1, 1), b3 + hstep, voffB);
            PG8_WAIT_V(6); PG8_BAR; PG8_MMA(1, 1, At, B1); PG8_BAR;
        }
        PG8_STAMP();
        if constexpr (!Epi::AFTER_DRAIN) { E(acc, cur, wr, wc, fr, fq); S.done(cur); }
        PG8_STAMP();
        if (!has_next) break;
#pragma unroll
        for (int a = 0; a < 2; ++a)
#pragma unroll
            for (int b = 0; b < 2; ++b)
#pragma unroll
                for (int m = 0; m < 4; ++m)
#pragma unroll
                    for (int n = 0; n < 2; ++n) acc[a][b][m][n] = (f32x4){0.f, 0.f, 0.f, 0.f};
        cur = nxt; cA = nA; cB = nB; ++ui;
    }
    PG8_WAIT_V(0);
    if (wr == 0) PG8_BAR;
    PG8_BAR;
    if constexpr (Epi::AFTER_DRAIN) { E.fused(acc, cur, wr, wc, fr, fq, lds, wid, lane); S.done(cur); }
    PG8_STAMP();
    if (STAMP && wid == 0) { stamps[lane] = lane < nts ? (((unsigned long long)(unsigned)ts_hi << 32) | (unsigned)ts_lo) : 0ull;
        if (lane == 62) stamps[62] = rt_entry; if (lane == 63) stamps[63] = (unsigned long long)wall_clock64(); }
#undef PG8_STAMP
#undef PG8_SA
#undef PG8_SB
#undef PG8_STAGE
#undef PG8_LDA
#undef PG8_LDB
#undef PG8_MMA
#undef PG8_WAIT_V
#undef PG8_WAIT_L
#undef PG8_BAR
#undef PG8_SCHED
}
}

namespace mk {
using pg8::bf16_t; using pg8::bf16x8; using pg8::f32x4; using pg8::u32x4; using pg8::cvt_pk_bf16;
typedef unsigned u32x2 __attribute__((ext_vector_type(2)));
constexpr int T = 24576, TP = 16384, SS = 2048, DM = 4096, NIN = 9216, DFF = 11008, NGU = 2 * DFF;
constexpr float ALPHA = 1.4142135623730951f;
constexpr float SC2 = 0.08838834764831845f * 1.4426950408889634f;
constexpr size_t OFF_BAR = 0, OFF_WIN = 16384, SZ_WIN = (size_t)2 * NIN * DM * 2, OFF_WOUT = OFF_WIN + SZ_WIN, SZ_WOUT = (size_t)2 * DM * DM * 2,
    OFF_WGU = OFF_WOUT + SZ_WOUT, SZ_WGU = (size_t)2 * NGU * DM * 2, OFF_WD = OFF_WGU + SZ_WGU, SZ_WD = (size_t)2 * DM * DFF * 2,
    OFF_XB = OFF_WD + SZ_WD, SZ_XB = (size_t)T * DM * 2, OFF_VT = OFF_XB + SZ_XB, SZ_VT = (size_t)20 * 128 * T * 2,
    OFF_PROJ = OFF_VT + SZ_VT, SZ_PROJ = (size_t)T * NIN * 2, OFF_MIX = OFF_PROJ + SZ_PROJ, SZ_MIX = (size_t)T * DM * 2, OFF_HDN = OFF_PROJ,
    WS_NEED = OFF_MIX + SZ_MIX;
static_assert((size_t)T * DFF * 2 <= SZ_PROJ + SZ_MIX, "hdn alias");

struct Params { const float* in[15]; float* out; unsigned char* ws; };

__device__ __forceinline__ float bf_lo(unsigned w) { return __uint_as_float(w << 16); }
__device__ __forceinline__ float bf_hi(unsigned w) { return __uint_as_float(w & 0xffff0000u); }

struct EpiResid {
    static constexpr bool PERM = false, AFTER_DRAIN = false;
    float* C; int ldc;
    __device__ __forceinline__ void operator()(const f32x4 (&acc)[2][2][4][2], const pg8::Unit& u, int wr, int wc, int fr, int fq) const {
        const int row0 = u.pm * 256 + wr * 64 + fr, col0 = u.pn * 256 + wc * 32 + 4 * fq;
#pragma unroll
        for (int ai = 0; ai < 2; ++ai)
#pragma unroll
            for (int m = 0; m < 4; ++m) { float* rowp = C + (size_t)(row0 + ai * 128 + m * 16) * ldc + col0;
#pragma unroll
                for (int bj = 0; bj < 2; ++bj)
#pragma unroll
                    for (int n = 0; n < 2; ++n) { f32x4 o = *(const f32x4*)(rowp + bj * 128 + n * 16); o = o * ALPHA + acc[ai][bj][m][n]; *(f32x4*)(rowp + bj * 128 + n * 16) = o; } }
    }
};
struct EpiSwiglu {
    static constexpr bool PERM = true, AFTER_DRAIN = false;
    bf16_t* O; int ldc;
    __device__ __forceinline__ void operator()(const f32x4 (&acc)[2][2][4][2], const pg8::Unit& u, int wr, int wc, int fr, int fq) const {
        const int row0 = u.pm * 256 + wr * 64 + fr, col0 = u.pn * 128 + wc * 32 + 8 * fq;
#pragma unroll
        for (int ai = 0; ai < 2; ++ai)
#pragma unroll
            for (int m = 0; m < 4; ++m) { bf16_t* rowp = O + (size_t)(row0 + ai * 128 + m * 16) * ldc + col0;
                float h[8];
#pragma unroll
                for (int n = 0; n < 2; ++n)
#pragma unroll
                    for (int e = 0; e < 4; ++e) { const float g = acc[ai][0][m][n][e], up = acc[ai][1][m][n][e]; h[n * 4 + e] = g * up * __builtin_amdgcn_rcpf(1.0f + __expf(-g)); }
                u32x4 w; w.x = cvt_pk_bf16(h[0], h[1]); w.y = cvt_pk_bf16(h[2], h[3]); w.z = cvt_pk_bf16(h[4], h[5]); w.w = cvt_pk_bf16(h[6], h[7]);
                *(u32x4*)rowp = w; }
    }
};

__device__ __forceinline__ void wt_phase(LAS unsigned char* lds, const Params& p) {
    LAS float* tile = (LAS float*)lds;
    const int tid = pg8::otid();
    for (int mi = 0; mi < 10; ++mi) {
        const int l = mi / 5, kind = mi % 5;
        const float* src; bf16_t* dst; int K, N, mode = 0;
        if (kind == 0)      { K = DM;  N = NIN; src = p.in[2]  + (size_t)l * K * N; dst = (bf16_t*)(p.ws + OFF_WIN)  + (size_t)l * NIN * DM; }
        else if (kind == 1) { K = DM;  N = DM;  src = p.in[7]  + (size_t)l * K * N; dst = (bf16_t*)(p.ws + OFF_WOUT) + (size_t)l * DM * DM; }
        else if (kind == 2) { K = DM;  N = DFF; src = p.in[10] + (size_t)l * K * N; dst = (bf16_t*)(p.ws + OFF_WGU)  + (size_t)l * NGU * DM; mode = 1; }
        else if (kind == 3) { K = DM;  N = DFF; src = p.in[11] + (size_t)l * K * N; dst = (bf16_t*)(p.ws + OFF_WGU)  + (size_t)l * NGU * DM; mode = 2; }
        else                { K = DFF; N = DM;  src = p.in[12] + (size_t)l * K * N; dst = (bf16_t*)(p.ws + OFF_WD)   + (size_t)l * DM * DFF; }
        const int nkt = K / 64, nnt = N / 64;
        for (int t = pg8::obid(); t < nkt * nnt; t += gridDim.x) {
            const int k0 = (t % nkt) * 64, n0 = (t / nkt) * 64;
            const int drow0 = mode == 0 ? n0 : ((n0 >> 7) * 256 + (n0 & 127) + (mode == 2 ? 128 : 0));
#pragma unroll
            for (int h = 0; h < 2; ++h) { const int kl = (tid >> 4) + 32 * h, n4 = (tid & 15) * 4;
                const f32x4 v = *(const f32x4*)(src + (size_t)(k0 + kl) * N + n0 + n4);
                tile[kl * 65 + n4 + 0] = v[0]; tile[kl * 65 + n4 + 1] = v[1]; tile[kl * 65 + n4 + 2] = v[2]; tile[kl * 65 + n4 + 3] = v[3]; }
            __syncthreads();
            const int nl = tid >> 3, k8 = (tid & 7) * 8;
            float f[8];
#pragma unroll
            for (int e = 0; e < 8; ++e) f[e] = tile[(k8 + e) * 65 + nl];
            u32x4 w; w.x = cvt_pk_bf16(f[0], f[1]); w.y = cvt_pk_bf16(f[2], f[3]); w.z = cvt_pk_bf16(f[4], f[5]); w.w = cvt_pk_bf16(f[6], f[7]);
            *(u32x4*)(dst + (size_t)(drow0 + nl) * K + k0 + k8) = w;
            __syncthreads();
        }
    }
}
__device__ __forceinline__ void xin_phase(const Params& p) {
    bf16_t* xb = (bf16_t*)(p.ws + OFF_XB);
    const size_t n4 = (size_t)T * DM / 4, np4 = (size_t)TP * DM / 4;
    for (size_t i = (size_t)pg8::obid() * 512 + pg8::otid(); i < n4; i += (size_t)gridDim.x * 512) {
        const f32x4 v = i < np4 ? ((const f32x4*)p.in[0])[i] : ((const f32x4*)p.in[1])[i - np4];
        ((f32x4*)p.out)[i] = v;
        u32x2 w; w.x = cvt_pk_bf16(v[0], v[1]); w.y = cvt_pk_bf16(v[2], v[3]); ((u32x2*)xb)[i] = w;
    }
}

__device__ __forceinline__ void prep_phase(LAS unsigned char* lds, const Params& p, int layer) {
    bf16_t* proj = (bf16_t*)(p.ws + OFF_PROJ);
    const int tid = pg8::otid(), j = tid & 15; const int bid = pg8::obid();
    const float* gq = p.in[3] + layer * 128; const float* gk = p.in[4] + layer * 128;
    for (int v = (bid * 512 + tid) >> 4; v < T * 36; v += gridDim.x * 32) {
        const int tok = v / 36, hv = v - tok * 36; const bool isB = hv >= 16;
        const int col = isB ? 3072 + (hv - 16) * 128 : hv * 128;
        bf16_t* ptr = proj + (size_t)tok * NIN + col + j * 8;
        const u32x4 raw = *(const u32x4*)ptr;
        float x[8] = {bf_lo(raw.x), bf_hi(raw.x), bf_lo(raw.y), bf_hi(raw.y), bf_lo(raw.z), bf_hi(raw.z), bf_lo(raw.w), bf_hi(raw.w)};
        float ss = 0.f;
#pragma unroll
        for (int e = 0; e < 8; ++e) ss += x[e] * x[e];
        ss += __shfl_xor(ss, 1); ss += __shfl_xor(ss, 2); ss += __shfl_xor(ss, 4); ss += __shfl_xor(ss, 8);
        const float r = rsqrtf(ss * (1.0f / 128.0f) + 1e-6f);
        const float* gp = (hv - 16 < 16) ? gq : gk;
        const int t = tok < TP ? tok : ((tok - TP) & (SS - 1));
        const bool act = isB || j < 4;
        const bool first = isB ? !(j & 4) : !(j & 2);
        const int ib = isB ? 8 * (j & 3) : 8 * (j & 1);
        const int pos = isB ? (j < 8 ? (t >> 6) : (t & 63)) : t;
        const double lf = isB ? (13.287712379549449 / 32.0) : (18.931568569324174 / 16.0);
#pragma unroll
        for (int e = 0; e < 8; ++e) {
            if (isB) x[e] = x[e] * r * gp[j * 8 + e];
        }
        float o[8];
#pragma unroll
        for (int e = 0; e < 8; ++e) {
            const float pa = __shfl_xor(x[e], 2), pb = __shfl_xor(x[e], 4);
            const float pr = isB ? pb : pa;
            const double inv = exp2(-(double)(ib + e) * lf);
            double rev = (double)pos * inv * 0.15915494309189535; rev -= floor(rev);
            const float fr = (float)rev;
            const float cs = __builtin_amdgcn_cosf(fr), sn = __builtin_amdgcn_sinf(fr);
            const float rot = first ? (x[e] * cs - pr * sn) : (x[e] * cs + pr * sn);
            o[e] = act ? rot : x[e];
        }
        u32x4 w; w.x = cvt_pk_bf16(o[0], o[1]); w.y = cvt_pk_bf16(o[2], o[3]); w.z = cvt_pk_bf16(o[4], o[5]); w.w = cvt_pk_bf16(o[6], o[7]);
        *(u32x4*)ptr = w;
    }
    bf16_t* vtg = (bf16_t*)(p.ws + OFF_VT);
    LAS bf16_t* vt = (LAS bf16_t*)lds;
    for (int tl = bid; tl < (T / 64) * 20; tl += gridDim.x) {
        const int tb = tl / 20, hh = tl - tb * 20;
        const int vcol = hh < 8 ? 2048 + hh * 128 : (hh < 12 ? 5632 + (hh - 8) * 128 : 8192 + (hh - 12) * 128);
#pragma unroll
        for (int h = 0; h < 2; ++h) { const int ch = tid + 512 * h, tokl = ch >> 4, part = ch & 15;
            const u32x4 raw = *(const u32x4*)(proj + (size_t)(tb * 64 + tokl) * NIN + vcol + part * 8);
            LAS unsigned* d = (LAS unsigned*)(vt + tokl * 130 + part * 8);
            d[0] = raw.x; d[1] = raw.y; d[2] = raw.z; d[3] = raw.w; }
        __syncthreads();
#pragma unroll
        for (int h = 0; h < 2; ++h) { const int ch = tid + 512 * h, d = ch & 127, tp = ch >> 7;
            unsigned short s[8];
#pragma unroll
            for (int e = 0; e < 8; ++e) s[e] = vt[(tp * 8 + e) * 130 + d];
            u32x4 w; w.x = s[0] | ((unsigned)s[1] << 16); w.y = s[2] | ((unsigned)s[3] << 16); w.z = s[4] | ((unsigned)s[5] << 16); w.w = s[6] | ((unsigned)s[7] << 16);
            *(u32x4*)(vtg + (size_t)(hh * 128 + d) * T + tb * 64 + tp * 8) = w; }
        __syncthreads();
    }
}

template <int MODE, int QT>
__device__ __forceinline__ void attn_item(LAS unsigned char* lds, const bf16_t* proj, const bf16_t* vtg, bf16_t* mixed, const float* rpb,
                                          int tok0, int bstart, int s, int head) {
    const int tid = pg8::otid(), w = tid >> 6, lane = tid & 63, c = lane & 15, g = lane >> 4;
    LAS unsigned char* Ks = lds;
    LAS unsigned char* Vs = lds + 17408;
    const int t0 = tok0 - bstart;
    int qcol, kcol, vhead, mcol, kb_lo, kb_hi, kbase;
    if (MODE == 0) { qcol = head * 128; kcol = 1024 + head * 128; vhead = head; mcol = head * 128; kbase = t0 - 1024;
        kb_lo = t0 >= 1024 ? 0 : (1024 - t0) >> 6; const int hi = (s - kbase) >> 6; kb_hi = hi < 36 ? hi : 36; }
    else if (MODE == 1) { qcol = 3072 + head * 128; kcol = 5120 + (head >> 2) * 128; vhead = 8 + (head >> 2); mcol = 1024 + head * 128; kbase = 0; kb_lo = 0; kb_hi = s >> 6; }
    else { qcol = 6144 + head * 128; kcol = 7168 + head * 128; vhead = 12 + head; mcol = 3072 + head * 128;
        const int rows = s >> 6, i0 = t0 >> 6; int rlo = i0 - 4; rlo = rlo < 0 ? 0 : (rlo > rows - 8 ? rows - 8 : rlo); int r1 = i0 - 3; r1 = r1 < 0 ? 0 : (r1 > rows - 8 ? rows - 8 : r1);
        kbase = rlo * 64; kb_lo = 0; kb_hi = r1 + 8 - rlo; }
    bf16x8 qf[QT][4];
#pragma unroll
    for (int qt = 0; qt < QT; ++qt)
#pragma unroll
        for (int ks = 0; ks < 4; ++ks) qf[qt][ks] = *(const bf16x8*)(proj + (size_t)(tok0 + (w * QT + qt) * 16 + c) * NIN + qcol + ks * 32 + g * 8);
    f32x4 oacc[QT][8]; float mrun[QT], lsum[QT];
#pragma unroll
    for (int qt = 0; qt < QT; ++qt) { mrun[qt] = -1e30f; lsum[qt] = 0.f;
#pragma unroll
        for (int dg = 0; dg < 8; ++dg) oacc[qt][dg] = (f32x4){0.f, 0.f, 0.f, 0.f}; }
    const int kkey = tid >> 4, kpart = tid & 15;
    const int vd = tid >> 3, vpart = tid & 7;
    const bf16_t* kg0 = proj + (long)(bstart + kbase + kkey) * NIN + kcol + kpart * 8;
    const bf16_t* vg0 = vtg + (long)(vhead * 128 + vd) * T + (long)(bstart + kbase + vpart * 8);
    u32x4 rk0, rk1, rv0, rv1;
    { const long ko = (long)kb_lo * 64 * NIN; rk0 = *(const u32x4*)(kg0 + ko); rk1 = *(const u32x4*)(kg0 + ko + (long)32 * NIN);
      const long vo = (long)kb_lo * 64; rv0 = *(const u32x4*)(vg0 + vo); rv1 = *(const u32x4*)(vg0 + vo + (long)64 * T); }
    for (int kb = kb_lo; kb < kb_hi; ++kb) {
        __syncthreads();
        *(LAS u32x4*)(Ks + (kkey * 136 + kpart * 8) * 2) = rk0; *(LAS u32x4*)(Ks + ((kkey + 32) * 136 + kpart * 8) * 2) = rk1;
        *(LAS u32x4*)(Vs + (vd * 72 + vpart * 8) * 2) = rv0; *(LAS u32x4*)(Vs + ((vd + 64) * 72 + vpart * 8) * 2) = rv1;
        __syncthreads();
        if (kb + 1 < kb_hi) { const long ko = (long)(kb + 1) * 64 * NIN; rk0 = *(const u32x4*)(kg0 + ko); rk1 = *(const u32x4*)(kg0 + ko + (long)32 * NIN);
            const long vo = (long)(kb + 1) * 64; rv0 = *(const u32x4*)(vg0 + vo); rv1 = *(const u32x4*)(vg0 + vo + (long)64 * T); }
        f32x4 sacc[QT][4];
#pragma unroll
        for (int qt = 0; qt < QT; ++qt)
#pragma unroll
            for (int kg = 0; kg < 4; ++kg) sacc[qt][kg] = (f32x4){0.f, 0.f, 0.f, 0.f};
#pragma unroll
        for (int ks = 0; ks < 4; ++ks)
#pragma unroll
            for (int kg = 0; kg < 4; ++kg) { const bf16x8 kf = *(const LAS bf16x8*)(Ks + ((kg * 16 + c) * 136 + ks * 32 + g * 8) * 2);
#pragma unroll
                for (int qt = 0; qt < QT; ++qt) sacc[qt][kg] = __builtin_amdgcn_mfma_f32_16x16x32_bf16(kf, qf[qt][ks], sacc[qt][kg], 0, 0, 0); }
        bf16x8 pf[QT][2];
#pragma unroll
        for (int qt = 0; qt < QT; ++qt) {
            const int qi = (w * QT + qt) * 16 + c;
            float x[4][4]; bool ok[4][4]; float mx = -1e30f;
#pragma unroll
            for (int kg = 0; kg < 4; ++kg)
#pragma unroll
                for (int e = 0; e < 4; ++e) { const int jk = kg * 16 + g * 4 + e; float v = sacc[qt][kg][e] * SC2; bool valid = true;
                    if (MODE == 0) { const int dl = 64 * kb + jk - qi - 1024, ad = dl < 0 ? -dl : dl;
                        const int mult = (ad <= 64 ? 1 : 0) + (((dl & 3) == 0 && ad <= 256) ? 1 : 0) + (((dl & 15) == 0 && ad <= 1024) ? 1 : 0);
                        valid = mult > 0; v += mult == 3 ? 1.5849625007211562f : (mult == 2 ? 1.0f : 0.0f); }
                    if (MODE == 2) { const int rows = s >> 6, ri = (t0 >> 6) + (qi >> 6), qc = qi & 63, rk = (kbase >> 6) + kb;
                        int rs = ri - 4; rs = rs < 0 ? 0 : (rs > rows - 8 ? rows - 8 : rs); int cst = qc - 8; cst = cst < 0 ? 0 : (cst > 48 ? 48 : cst);
                        valid = rk >= rs && rk < rs + 8 && jk >= cst && jk < cst + 16;
                        if (valid) v += rpb[head * 465 + (rk - ri + 7) * 31 + (jk - qc + 15)] * 1.4426950408889634f; }
                    x[kg][e] = v; ok[kg][e] = valid; mx = valid ? fmaxf(mx, v) : mx; }
            mx = fmaxf(mx, __shfl_xor(mx, 16)); mx = fmaxf(mx, __shfl_xor(mx, 32));
            const float mnew = fmaxf(mrun[qt], mx), alpha = __builtin_amdgcn_exp2f(mrun[qt] - mnew); mrun[qt] = mnew;
            float ps = 0.f; float pv[4][4];
#pragma unroll
            for (int kg = 0; kg < 4; ++kg)
#pragma unroll
                for (int e = 0; e < 4; ++e) { const float pe = ok[kg][e] ? __builtin_amdgcn_exp2f(x[kg][e] - mnew) : 0.f; pv[kg][e] = pe; ps += pe; }
            lsum[qt] = lsum[qt] * alpha + ps;
#pragma unroll
            for (int dg = 0; dg < 8; ++dg) oacc[qt][dg] *= alpha;
#pragma unroll
            for (int sI = 0; sI < 2; ++sI) { u32x4 pw; pw.x = cvt_pk_bf16(pv[2 * sI][0], pv[2 * sI][1]); pw.y = cvt_pk_bf16(pv[2 * sI][2], pv[2 * sI][3]);
                pw.z = cvt_pk_bf16(pv[2 * sI + 1][0], pv[2 * sI + 1][1]); pw.w = cvt_pk_bf16(pv[2 * sI + 1][2], pv[2 * sI + 1][3]);
                pf[qt][sI] = __builtin_bit_cast(bf16x8, pw); }
        }
#pragma unroll
        for (int sI = 0; sI < 2; ++sI)
#pragma unroll
            for (int dg = 0; dg < 8; ++dg) { const LAS unsigned char* vp = Vs + ((dg * 16 + c) * 72 + 32 * sI + g * 4) * 2;
                const u32x2 a0 = *(const LAS u32x2*)vp, a1 = *(const LAS u32x2*)(vp + 32);
                u32x4 vw; vw.x = a0.x; vw.y = a0.y; vw.z = a1.x; vw.w = a1.y; const bf16x8 vf = __builtin_bit_cast(bf16x8, vw);
#pragma unroll
                for (int qt = 0; qt < QT; ++qt) oacc[qt][dg] = __builtin_amdgcn_mfma_f32_16x16x32_bf16(vf, pf[qt][sI], oacc[qt][dg], 0, 0, 0); }
    }
#pragma unroll
    for (int qt = 0; qt < QT; ++qt) {
        float l = lsum[qt]; l += __shfl_xor(l, 16); l += __shfl_xor(l, 32);
        const float inv = 1.0f / l;
        bf16_t* op = mixed + (size_t)(tok0 + (w * QT + qt) * 16 + c) * DM + mcol + g * 4;
#pragma unroll
        for (int dg = 0; dg < 8; ++dg) { const f32x4 o = oacc[qt][dg] * inv; u32x2 ow; ow.x = cvt_pk_bf16(o[0], o[1]); ow.y = cvt_pk_bf16(o[2], o[3]); *(u32x2*)(op + dg * 16) = ow; }
    }
}

__device__ __forceinline__ void attn_phase(LAS unsigned char* lds, const Params& p, int layer) {
    const bf16_t* proj = (const bf16_t*)(p.ws + OFF_PROJ); const bf16_t* vtg = (const bf16_t*)(p.ws + OFF_VT); bf16_t* mixed = (bf16_t*)(p.ws + OFF_MIX);
    const float* rpb = p.in[5] + layer * (8 * 15 * 31);
    for (int it = pg8::obid(); it < 1024; it += gridDim.x) { const int head = it & 15, qb = it >> 4; attn_item<1, 2>(lds, proj, vtg, mixed, rpb, qb * 256, 0, TP, head); }
    for (int it = pg8::obid(); it < 512; it += gridDim.x) { const int head = it & 15, qb = it >> 4; attn_item<1, 2>(lds, proj, vtg, mixed, rpb, TP + qb * 256, TP + (qb >> 3) * SS, SS, head); }
    for (int it = pg8::obid(); it < 1536; it += gridDim.x) { const int head = it & 7, tok0 = (it >> 3) * 128; const bool pr = tok0 < TP; const int bs = pr ? 0 : TP + ((tok0 - TP) / SS) * SS;
        attn_item<0, 1>(lds, proj, vtg, mixed, rpb, tok0, bs, pr ? TP : SS, head); }
    for (int it = pg8::obid(); it < 1536; it += gridDim.x) { const int head = it & 7, tok0 = (it >> 3) * 128; const bool pr = tok0 < TP; const int bs = pr ? 0 : TP + ((tok0 - TP) / SS) * SS;
        attn_item<2, 1>(lds, proj, vtg, mixed, rpb, tok0, bs, pr ? TP : SS, head); }
}

__device__ __forceinline__ void grms_phase(const Params& p, int layer) {
    bf16_t* mixed = (bf16_t*)(p.ws + OFF_MIX); const float* gg = p.in[6] + layer * DM;
    const int tid0 = pg8::otid(), lane = tid0 & 63, wv = tid0 >> 6; const int bid = pg8::obid();
    for (int tok = bid * 8 + wv; tok < T; tok += gridDim.x * 8) {
        bf16_t* row = mixed + (size_t)tok * DM;
        u32x4 raw[8]; float ssq[3] = {0.f, 0.f, 0.f};
#pragma unroll
        for (int k = 0; k < 8; ++k) { raw[k] = *(const u32x4*)(row + (lane + 64 * k) * 8);
            const float a0 = bf_lo(raw[k].x), a1 = bf_hi(raw[k].x), a2 = bf_lo(raw[k].y), a3 = bf_hi(raw[k].y), a4 = bf_lo(raw[k].z), a5 = bf_hi(raw[k].z), a6 = bf_lo(raw[k].w), a7 = bf_hi(raw[k].w);
            const float q = a0 * a0 + a1 * a1 + a2 * a2 + a3 * a3 + a4 * a4 + a5 * a5 + a6 * a6 + a7 * a7;
            ssq[k < 2 ? 0 : (k < 6 ? 1 : 2)] += q; }
        float sc[3];
#pragma unroll
        for (int gI = 0; gI < 3; ++gI) { float v = ssq[gI];
#pragma unroll
            for (int o = 32; o >= 1; o >>= 1) v += __shfl_xor(v, o);
            sc[gI] = rsqrtf(v / (gI == 1 ? 2048.0f : 1024.0f) + 1e-6f); }
#pragma unroll
        for (int k = 0; k < 8; ++k) { const float r = sc[k < 2 ? 0 : (k < 6 ? 1 : 2)]; const int col = (lane + 64 * k) * 8;
            const f32x4 g0 = *(const f32x4*)(gg + col), g1 = *(const f32x4*)(gg + col + 4);
            u32x4 w; w.x = cvt_pk_bf16(bf_lo(raw[k].x) * r * g0[0], bf_hi(raw[k].x) * r * g0[1]); w.y = cvt_pk_bf16(bf_lo(raw[k].y) * r * g0[2], bf_hi(raw[k].y) * r * g0[3]);
            w.z = cvt_pk_bf16(bf_lo(raw[k].z) * r * g1[0], bf_hi(raw[k].z) * r * g1[1]); w.w = cvt_pk_bf16(bf_lo(raw[k].w) * r * g1[2], bf_hi(raw[k].w) * r * g1[3]);
            *(u32x4*)(row + col) = w; }
    }
}
__device__ __forceinline__ void ln_phase(const Params& p, const float* gam, const float* bet) {
    bf16_t* xb = (bf16_t*)(p.ws + OFF_XB);
    const int tid0 = pg8::otid(), lane = tid0 & 63, wv = tid0 >> 6; const int bid = pg8::obid();
    for (int tok = bid * 8 + wv; tok < T; tok += gridDim.x * 8) {
        float* row = p.out + (size_t)tok * DM;
        f32x4 v[16]; float s = 0.f;
#pragma unroll
        for (int k = 0; k < 16; ++k) { v[k] = *(const f32x4*)(row + (lane + 64 * k) * 4); s += (v[k][0] + v[k][1]) + (v[k][2] + v[k][3]); }
#pragma unroll
        for (int o = 32; o >= 1; o >>= 1) s += __shfl_xor(s, o);
        const float mean = s * (1.0f / DM); float q = 0.f;
#pragma unroll
        for (int k = 0; k < 16; ++k) { const f32x4 d = v[k] - mean; q += (d[0] * d[0] + d[1] * d[1]) + (d[2] * d[2] + d[3] * d[3]); }
#pragma unroll
        for (int o = 32; o >= 1; o >>= 1) q += __shfl_xor(q, o);
        const float rstd = rsqrtf(q * (1.0f / DM) + 1e-5f);
#pragma unroll
        for (int k = 0; k < 16; ++k) { const int col = (lane + 64 * k) * 4; const f32x4 gv = *(const f32x4*)(gam + col), bv = *(const f32x4*)(bet + col);
            const f32x4 o = (v[k] - mean) * rstd * gv + bv; *(f32x4*)(row + col) = o;
            u32x2 w; w.x = cvt_pk_bf16(o[0], o[1]); w.y = cvt_pk_bf16(o[2], o[3]); *(u32x2*)(xb + (size_t)tok * DM + col) = w; }
    }
}

__global__ __launch_bounds__(512, 2) void fwd(Params p) {
    extern __shared__ __attribute__((aligned(16))) unsigned char shm[];
    LAS unsigned char* lds = (LAS unsigned char*)shm;
    volatile LAS unsigned* xbw = (volatile LAS unsigned*)(lds + pg8::STAGE_BYTES);
    if (threadIdx.x < 4) xbw[threadIdx.x] = 0u;
    __syncthreads();
    XcdBarrier bar = xcd_barrier_post((unsigned*)(p.ws + OFF_BAR), xbw);
    const int G = (int)gridDim.x;
    wt_phase(lds, p);
    xin_phase(p);
    xcd_barrier(bar);
    bf16_t* xb = (bf16_t*)(p.ws + OFF_XB); bf16_t* proj = (bf16_t*)(p.ws + OFF_PROJ); bf16_t* mixed = (bf16_t*)(p.ws + OFF_MIX); bf16_t* hdn = (bf16_t*)(p.ws + OFF_HDN);
#pragma unroll 1
    for (int l = 0; l < 2; ++l) {
        { pg8::Gemm g{xb, (const bf16_t*)(p.ws + OFF_WIN) + (size_t)l * NIN * DM, T, NIN, DM}; pg8::StaticOrder S; S.init(T, NIN, G, pg8::obid());
          pg8::EpiBf16<0> E{proj, NIN, nullptr, 0, 0}; pg8::gemm_phase<pg8::EpiBf16<0>, pg8::StaticOrder, false>(lds, g, S, E, nullptr); }
        xcd_barrier(bar);
        prep_phase(lds, p, l);
        xcd_barrier(bar);
        attn_phase(lds, p, l);
        xcd_barrier(bar);
        grms_phase(p, l);
        xcd_barrier(bar);
        { pg8::Gemm g{mixed, (const bf16_t*)(p.ws + OFF_WOUT) + (size_t)l * DM * DM, T, DM, DM}; pg8::StaticOrder S; S.init(T, DM, G, pg8::obid());
          EpiResid E{p.out, DM}; pg8::gemm_phase<EpiResid, pg8::StaticOrder, false>(lds, g, S, E, nullptr); }
        xcd_barrier(bar);
        ln_phase(p, p.in[8] + l * DM, p.in[9] + l * DM);
        xcd_barrier(bar);
        { pg8::Gemm g{xb, (const bf16_t*)(p.ws + OFF_WGU) + (size_t)l * NGU * DM, T, NGU, DM}; pg8::StaticOrder S; S.init(T, NGU, G, pg8::obid());
          EpiSwiglu E{hdn, DFF}; pg8::gemm_phase<EpiSwiglu, pg8::StaticOrder, false>(lds, g, S, E, nullptr); }
        xcd_barrier(bar);
        { pg8::Gemm g{hdn, (const bf16_t*)(p.ws + OFF_WD) + (size_t)l * DM * DFF, T, DM, DFF}; pg8::StaticOrder S; S.init(T, DM, G, pg8::obid());
          EpiResid E{p.out, DM}; pg8::gemm_phase<EpiResid, pg8::StaticOrder, false>(lds, g, S, E, nullptr); }
        xcd_barrier(bar);
        ln_phase(p, p.in[13] + l * DM, p.in[14] + l * DM);
        xcd_barrier(bar);
    }
}
}

extern "C" void kernel_launch(void* const* d_in, const int* in_sizes, int n_in, void* d_out, int out_size, void* d_ws, size_t ws_size, hipStream_t stream) {
    constexpr int LDSB = pg8::STAGE_BYTES + 16;
    static int grid = 0;
    if (!grid) {
        int dev = 0, cus = 0, per_cu = 0;
        hipGetDevice(&dev);
        hipDeviceGetAttribute(&cus, hipDeviceAttributeMultiprocessorCount, dev);
        if (hipFuncSetAttribute((const void*)mk::fwd, hipFuncAttributeMaxDynamicSharedMemorySize, LDSB) != hipSuccess) { fprintf(stderr, "hipFuncSetAttribute failed\n"); grid = -1; }
        else if (hipOccupancyMaxActiveBlocksPerMultiprocessor(&per_cu, (const void*)mk::fwd, 512, LDSB) != hipSuccess || per_cu < 1) { fprintf(stderr, "occupancy query failed\n"); grid = -1; }
        else grid = cus;
    }
    if (grid <= 0 || ws_size < mk::WS_NEED || n_in < 15) { fprintf(stderr, "kernel_launch: refused (grid %d, ws %zu need %zu)\n", grid, ws_size, (size_t)mk::WS_NEED); return; }
    hipMemsetAsync((unsigned char*)d_ws + mk::OFF_BAR, 0, 16384, stream);
    mk::Params p{};
    for (int i = 0; i < 15; ++i) p.in[i] = (const float*)d_in[i];
    p.out = (float*)d_out; p.ws = (unsigned char*)d_ws;
    hipLaunchKernelGGL(mk::fwd, dim3(grid), dim3(512), LDSB, stream, p);
}
```

```cpp
#include <hip/hip_runtime.h>
#include <cstdio>
#include <cstdint>
#define XB_TMO      128
#define XB_XCNT(j)  (256  + 64 * (j))
#define XB_XSUB(j)  (1280 + 64 * (j))
#define XB_XGEN(j)  (2304 + 64 * (j))
#define XB_TOP      3328
#define XB_TOPGEN   3392
#define XCD_BAR_WORDS 3456
#define XB_SPIN_CAP (1u << 18)
#define LAS __attribute__((address_space(3)))

__device__ __forceinline__ unsigned xb_ld(unsigned* p)              { return __hip_atomic_load(p, __ATOMIC_RELAXED, __HIP_MEMORY_SCOPE_AGENT); }
__device__ __forceinline__ unsigned xb_add(unsigned* p, unsigned v) { return __hip_atomic_fetch_add(p, v, __ATOMIC_RELAXED, __HIP_MEMORY_SCOPE_AGENT); }
__device__ __forceinline__ unsigned xb_xcc_id() { return (unsigned)__builtin_amdgcn_s_getreg((3 << 11) | 20) & 0xFu; }
#define XB_SPIN(cond, bar) do { unsigned _sp = 0; while (cond) { __builtin_amdgcn_s_sleep(1); \
    if ((++_sp & 255u) == 0u) { if (xb_ld(&(bar)[XB_TMO])) break; if (_sp > XB_SPIN_CAP) { atomicAdd(&(bar)[XB_TMO], 1u); break; } } } } while (0)

struct XcdBarrier {
    unsigned* bar; unsigned x;
    volatile LAS unsigned* st;
};

__device__ __forceinline__ XcdBarrier xcd_barrier_post(unsigned* bar, volatile LAS unsigned* st) {
    XcdBarrier b; b.bar = bar; b.x = xb_xcc_id(); b.st = st;
    if (threadIdx.x == 0) (void)xb_add(&bar[XB_XCNT(b.x)], 1u);
    return b;
}
__device__ __forceinline__ void xcd_barrier_complete(unsigned* bar, unsigned x, unsigned& nloc, unsigned& nx) {
    const unsigned G = gridDim.x * gridDim.y * gridDim.z;
    unsigned sum, cnt, mine, sp = 0u;
    for (;;) {
        sum = 0u; cnt = 0u; mine = 0u;
#pragma unroll
        for (unsigned j = 0; j < 16; ++j) { const unsigned c = xb_ld(&bar[XB_XCNT(j)]); sum += c; cnt += (c > 0u) ? 1u : 0u; mine = (j == x) ? c : mine; }
        if (sum == G) break;
        __builtin_amdgcn_s_sleep(1);
        if ((++sp & 255u) == 0u) { if (xb_ld(&bar[XB_TMO])) break; if (sp > XB_SPIN_CAP) { atomicAdd(&bar[XB_TMO], 1u); break; } }
    }
    nloc = mine > 0u ? mine : 1u; nx = cnt > 0u ? cnt : 1u;
}

__device__ __forceinline__ void xcd_barrier(const XcdBarrier& b) {
    asm volatile("s_waitcnt vmcnt(0)" ::: "memory");
    __syncthreads();
    if (threadIdx.x == 0) {
        unsigned* bar = b.bar; unsigned bx = xb_xcc_id(); asm volatile("" : "+s"(bx));
        __builtin_amdgcn_s_waitcnt(0);
        unsigned nloc = b.st[0], nx = b.st[1];
        if (nloc == 0u) { xcd_barrier_complete(bar, bx, nloc, nx); b.st[0] = nloc; b.st[1] = nx; }
        const unsigned old = xb_add(&bar[XB_XSUB(bx)], 1u);
        const unsigned gen = old / nloc;
        if (old + 1u == (gen + 1u) * nloc) {
            __builtin_amdgcn_fence(__ATOMIC_RELEASE, "agent");
            asm volatile("s_waitcnt vmcnt(0)" ::: "memory");
            const unsigned og = xb_add(&bar[XB_TOP], 1u);
            const unsigned tg = og / nx;
            if (og + 1u == (tg + 1u) * nx) xb_add(&bar[XB_TOPGEN], 1u);
            else XB_SPIN(xb_ld(&bar[XB_TOPGEN]) == tg, bar);
            __builtin_amdgcn_fence(__ATOMIC_ACQUIRE, "agent");
            xb_add(&bar[XB_XGEN(bx)], 1u);
            asm volatile("s_waitcnt vmcnt(0)" ::: "memory");
        } else {
            XB_SPIN(xb_ld(&bar[XB_XGEN(bx)]) == gen, bar);
            __builtin_amdgcn_fence(__ATOMIC_ACQUIRE, "agent");
            asm volatile("s_waitcnt vmcnt(0)" ::: "memory");
        }
    }
    __syncthreads();
}
namespace pg8 {
__device__ __forceinline__ int otid() { int t = (int)threadIdx.x; asm volatile("" : "+v"(t)); return t; }
__device__ __forceinline__ int obid() { int b = (int)blockIdx.x; asm volatile("" : "+s"(b)); return b; }

#define PG8_LAS __attribute__((address_space(3)))
typedef unsigned short bf16_t;
typedef short bf16x8 __attribute__((ext_vector_type(8)));
typedef float f32x4 __attribute__((ext_vector_type(4)));
typedef unsigned u32x4 __attribute__((ext_vector_type(4)));
constexpr int BM = 256, BK = 64, HALF = 128, HTB = HALF * BK * 2  , STAGE_BYTES = 8 * HTB, NXCD = 8, WGM = 8;

__host__ __device__ __forceinline__ int lds_byte(int r, int c) { const int st = (r >> 4) * 2 + (c >> 5), rr = r & 15, cc = c & 31, ob = rr * 64 + cc * 2; return st * 1024 + (ob ^ (((ob >> 9) & 1) << 5)); }
__host__ __device__ __forceinline__ void stage_rc(int b, int& R, int& C) { const int st = b / 1024, sb = b % 1024, swz = sb ^ (((sb >> 9) & 1) << 5); R = (st >> 1) * 16 + swz / 64; C = (st & 1) * 32 + (swz % 64) / 2; }
__host__ __device__ __forceinline__ int perm32(int rho) { const int n = rho >> 4, i = rho & 15; return 8 * (i >> 2) + 4 * n + (i & 3); }

struct Unit { int pm, pn; };
struct Gemm { const bf16_t* A; const bf16_t* Bt; int M, N, K; };

struct StaticOrder {
    int nM, nN, nwg, G, c;
    __host__ __device__ void init(int M, int N, int G_, int c_) { nM = M / BM; nN = N / BM; nwg = nM * nN; G = G_; c = c_; }
    __host__ __device__ bool next(int i, Unit& u) const {
        const long L = (long)i * G + c; if (L >= nwg) return false;
        int wgid = (int)L; { const int q = nwg / NXCD, r = nwg % NXCD, xcd = wgid % NXCD, off = wgid / NXCD; wgid = (xcd < r ? xcd * (q + 1) : r * (q + 1) + (xcd - r) * q) + off; }
        const int nig = WGM * nN, gid = wgid / nig, fm = gid * WGM, gsz = (nM - fm) < WGM ? (nM - fm) : WGM;
        u.pm = fm + ((wgid % nig) % gsz); u.pn = (wgid % nig) / gsz; return true;
    }
    __device__ __forceinline__ void a_ready(const Unit&) const {}
    __device__ __forceinline__ void done(const Unit&) const {}
};
struct CountedOrder : StaticOrder {
    const unsigned* ready; unsigned need; unsigned* tmo;
    __device__ __forceinline__ void a_ready(const Unit& u) const {
        if (threadIdx.x < 64) {
            const unsigned long long t0 = __builtin_amdgcn_s_memrealtime(); unsigned polls = 0;
            while ((unsigned)__builtin_amdgcn_readfirstlane(__hip_atomic_load(ready + 64 * u.pm, __ATOMIC_RELAXED, __HIP_MEMORY_SCOPE_AGENT)) < need) {
                if ((++polls & 255u) == 0u && __builtin_amdgcn_readfirstlane(__hip_atomic_load(tmo, __ATOMIC_RELAXED, __HIP_MEMORY_SCOPE_AGENT)) != 0u) break;
                if (__builtin_amdgcn_s_memrealtime() - t0 > 2000000ull) {
                    if (threadIdx.x == 0) { unsigned expect = 0u; __hip_atomic_compare_exchange_strong(tmo + 1, &expect, 0x600u | (unsigned)(u.pm & 0xff), __ATOMIC_RELAXED, __ATOMIC_RELAXED, __HIP_MEMORY_SCOPE_AGENT); __hip_atomic_store(tmo, 1u, __ATOMIC_RELAXED, __HIP_MEMORY_SCOPE_AGENT); }
                    break; }
                __builtin_amdgcn_s_sleep(2); }
            __builtin_amdgcn_fence(__ATOMIC_ACQUIRE, "agent");
            asm volatile("s_waitcnt vmcnt(0)" ::: "memory");
        }
#if !defined(BROKEN_HOOK_NO_BARRIER)
        asm volatile("" ::: "memory"); __builtin_amdgcn_s_barrier(); asm volatile("" ::: "memory");
#endif
    }
};

__device__ __forceinline__ unsigned cvt_pk_bf16(float lo, float hi) { unsigned r; asm volatile("v_cvt_pk_bf16_f32 %0, %1, %2" : "=v"(r) : "v"(lo), "v"(hi)); return r; }
typedef float f32x2 __attribute__((ext_vector_type(2)));
__device__ __forceinline__ f32x2 gelu_pk(f32x2 v) {
    const f32x2 av = __builtin_elementwise_abs(v), d = av * 0.2316418882f + 1.0f;
    f32x2 t; t.x = __builtin_amdgcn_rcpf(d.x); t.y = __builtin_amdgcn_rcpf(d.y);
    f32x2 q = t * 0.5307027145f + (-0.7265760135f); q = q * t + 0.7107068705f; q = q * t + (-0.142248368f); q = q * t + 0.127414796f; q = q * t;
    const f32x2 s = (v * v) * (-0.72134752044f);
    f32x2 e; e.x = __builtin_amdgcn_exp2f(s.x); e.y = __builtin_amdgcn_exp2f(s.y);
    const f32x2 m = v * (q * e), r = v - m;
    f32x2 o; o.x = v.x < 0.f ? m.x : r.x; o.y = v.y < 0.f ? m.y : r.y; return o;
}

struct EpiF32 {
    static constexpr bool PERM = false, AFTER_DRAIN = false;
    float* C; int ldc; const float* bias;
    __device__ __forceinline__ void operator()(const f32x4 (&acc)[2][2][4][2], const Unit& u, int wr, int wc, int fr, int fq) const {
        const int row0 = u.pm * BM + wr * 64 + fr, col0 = u.pn * BM + wc * 32 + 4 * fq;
        f32x4 bv[2][2];
#pragma unroll
        for (int bj = 0; bj < 2; ++bj)
#pragma unroll
            for (int n = 0; n < 2; ++n) bv[bj][n] = bias ? *(const f32x4*)(bias + col0 + bj * HALF + n * 16) : (f32x4){0.f, 0.f, 0.f, 0.f};
#pragma unroll
        for (int ai = 0; ai < 2; ++ai)
#pragma unroll
            for (int m = 0; m < 4; ++m) { float* rowp = C + (size_t)(row0 + ai * HALF + m * 16) * ldc + col0;
#pragma unroll
                for (int bj = 0; bj < 2; ++bj)
#pragma unroll
                    for (int n = 0; n < 2; ++n) *(f32x4*)(rowp + bj * HALF + n * 16) = acc[ai][bj][m][n] + bv[bj][n]; }
    }
};
template <int ACT  > struct EpiBf16 {
    static constexpr bool PERM = true, AFTER_DRAIN = false;
    bf16_t* O; int ldc; const float* bias; int split_cols; size_t split_stride;
    __device__ __forceinline__ void operator()(const f32x4 (&acc)[2][2][4][2], const Unit& u, int wr, int wc, int fr, int fq) const {
        const int row0 = u.pm * BM + wr * 64 + fr; int colt = u.pn * BM; bf16_t* base = O;
        if (split_cols) { const int t = colt / split_cols; base += (size_t)t * split_stride; colt -= t * split_cols; }
        const int col0 = colt + wc * 32 + 8 * fq, bcol0 = u.pn * BM + wc * 32 + 8 * fq;
        f32x4 bv[2][2];
#pragma unroll
        for (int bj = 0; bj < 2; ++bj)
#pragma unroll
            for (int n = 0; n < 2; ++n) bv[bj][n] = bias ? *(const f32x4*)(bias + bcol0 + bj * HALF + 4 * n) : (f32x4){0.f, 0.f, 0.f, 0.f};
#pragma unroll
        for (int ai = 0; ai < 2; ++ai)
#pragma unroll
            for (int m = 0; m < 4; ++m) { bf16_t* rowp = base + (size_t)(row0 + ai * HALF + m * 16) * ldc + col0;
#pragma unroll
                for (int bj = 0; bj < 2; ++bj) { f32x4 v0 = acc[ai][bj][m][0] + bv[bj][0], v1 = acc[ai][bj][m][1] + bv[bj][1];
                    if (ACT == 1) { f32x2 a = gelu_pk((f32x2){v0[0], v0[1]}), b = gelu_pk((f32x2){v0[2], v0[3]}), c = gelu_pk((f32x2){v1[0], v1[1]}), d = gelu_pk((f32x2){v1[2], v1[3]});
                        v0 = (f32x4){a.x, a.y, b.x, b.y}; v1 = (f32x4){c.x, c.y, d.x, d.y}; }
                    if (ACT == 2) {
#pragma unroll
                        for (int j = 0; j < 4; ++j) { v0[j] = 0.5f * v0[j] * (1.0f + erff(v0[j] * 0.70710678f)); v1[j] = 0.5f * v1[j] * (1.0f + erff(v1[j] * 0.70710678f)); } }
                    u32x4 w; w.x = cvt_pk_bf16(v0[0], v0[1]); w.y = cvt_pk_bf16(v0[2], v0[3]); w.z = cvt_pk_bf16(v1[0], v1[1]); w.w = cvt_pk_bf16(v1[2], v1[3]);
                    *(u32x4*)(rowp + bj * HALF) = w; } }
    }
};
template <class Epi, class Sched, bool STAMP = false>
__device__ __forceinline__ void gemm_phase(PG8_LAS unsigned char* lds, const Gemm g, const Sched& S, const Epi& E, unsigned long long* stamps) {
    const int tid = otid(), wid = __builtin_amdgcn_readfirstlane(tid >> 6), lane = tid & 63, wr = wid >> 2, wc = wid & 3, fr = lane & 15, fq = lane >> 4;
    const int K = g.K, nt = K / BK;
    int ts_lo = 0, ts_hi = 0, nts = 0; const unsigned long long rt_entry = STAMP ? (unsigned long long)wall_clock64() : 0ull;
#define PG8_STAMP() do { if (STAMP && wid == 0 && nts < 64) { const unsigned long long _c = (unsigned long long)clock64(); \
        ts_lo = (lane == nts) ? (int)(unsigned)_c : ts_lo; ts_hi = (lane == nts) ? (int)(unsigned)(_c >> 32) : ts_hi; ++nts; } } while (0)
    PG8_STAMP();
    unsigned voffA[2], voffB[2];
#pragma unroll
    for (int i = 0; i < 2; ++i) { int R, C; stage_rc(tid * 16 + i * 8192, R, C); const int Rb = Epi::PERM ? ((R & ~31) + perm32(R & 31)) : R;
        voffA[i] = (unsigned)(R * K + C) * 2u; voffB[i] = (unsigned)(Rb * K + C) * 2u; }
    const size_t kstep = (size_t)(BK * 2);
    const size_t hstep = (size_t)HALF * K * 2;
    const size_t tstep = 2 * hstep;
    const unsigned ldsw = (unsigned)wid * 1024u;
    const int aoff = lds_byte(wr * 64 + fr, fq * 8), boff = lds_byte(wc * 32 + fr, fq * 8);
#define PG8_SA(b, h) (((b) * 2 + (h)) * HTB)
#define PG8_SB(b, h) ((4 + (b) * 2 + (h)) * HTB)
#define PG8_STAGE(bufoff, gbase, voff) do { _Pragma("unroll") for (int _i = 0; _i < 2; ++_i) \
        __builtin_amdgcn_global_load_lds((const unsigned*)((const char*)(gbase) + (voff)[_i]), (PG8_LAS unsigned*)(lds + (bufoff) + ldsw + _i * 8192), 16, 0, 0); } while (0)
#define PG8_LDA(dst, b, h) do { _Pragma("unroll") for (int m = 0; m < 4; ++m) _Pragma("unroll") for (int k = 0; k < 2; ++k) dst[m][k] = *(const PG8_LAS bf16x8*)(lds + PG8_SA(b, h) + aoff + m * 2048 + k * 1024); } while (0)
#define PG8_LDB(dst, b, h) do { _Pragma("unroll") for (int n = 0; n < 2; ++n) _Pragma("unroll") for (int k = 0; k < 2; ++k) dst[n][k] = *(const PG8_LAS bf16x8*)(lds + PG8_SB(b, h) + boff + n * 2048 + k * 1024); } while (0)
#define PG8_MMA(ai, bj, At, Bt) do { __builtin_amdgcn_s_setprio(1); _Pragma("unroll") for (int m = 0; m < 4; ++m) _Pragma("unroll") for (int n = 0; n < 2; ++n) _Pragma("unroll") for (int k = 0; k < 2; ++k) \
        acc[ai][bj][m][n] = __builtin_amdgcn_mfma_f32_16x16x32_bf16(Bt[n][k], At[m][k], acc[ai][bj][m][n], 0, 0, 0); __builtin_amdgcn_s_setprio(0); } while (0)
#define PG8_WAIT_V(n) asm volatile("s_waitcnt vmcnt(" #n ")" ::: "memory")
#define PG8_WAIT_L(n) asm volatile("s_waitcnt lgkmcnt(" #n ")" ::: "memory")
#define PG8_BAR __builtin_amdgcn_s_barrier()
#define PG8_SCHED __builtin_amdgcn_sched_barrier(0)
    Unit cur, nxt; int ui = 0;
    if (!S.next(0, cur)) return;
    f32x4 acc[2][2][4][2];
#pragma unroll
    for (int a = 0; a < 2; ++a)
#pragma unroll
        for (int b = 0; b < 2; ++b)
#pragma unroll
            for (int m = 0; m < 4; ++m)
#pragma unroll
                for (int n = 0; n < 2; ++n) acc[a][b][m][n] = (f32x4){0.f, 0.f, 0.f, 0.f};
    bf16x8 At[4][2], B0[2][2], B1[2][2];
    const char* cA = (const char*)g.A + (size_t)cur.pm * tstep; const char* cB = (const char*)g.Bt + (size_t)cur.pn * tstep;
    S.a_ready(cur);
    PG8_STAGE(PG8_SB(0, 0), cB, voffB); PG8_STAGE(PG8_SA(0, 0), cA, voffA); PG8_STAGE(PG8_SB(0, 1), cB + hstep, voffB); PG8_STAGE(PG8_SA(0, 1), cA + hstep, voffA);
    if (wr == 1) PG8_BAR;
    PG8_WAIT_V(4); PG8_BAR;
    PG8_STAGE(PG8_SB(1, 0), cB + kstep, voffB); PG8_STAGE(PG8_SA(1, 0), cA + kstep, voffA); PG8_STAGE(PG8_SB(1, 1), cB + hstep + kstep, voffB);
    PG8_WAIT_V(6); PG8_BAR;
    PG8_STAMP();
    for (;;) {
        const bool has_next = S.next(ui + 1, nxt);
        const char* nA = has_next ? (const char*)g.A + (size_t)nxt.pm * tstep : cA; const char* nB = has_next ? (const char*)g.Bt + (size_t)nxt.pn * tstep : cB;
        for (int t = 0; t < nt; t += 2) {
            const bool last = (t == nt - 2);
            const char* a1 = cA + (size_t)(t + 1) * kstep;
            const char* a2 = last ? nA : cA + (size_t)(t + 2) * kstep; const char* b2 = last ? nB : cB + (size_t)(t + 2) * kstep;
            const char* a3 = a2 + kstep; const char* b3 = b2 + kstep;
            if (last && has_next) S.a_ready(nxt);
            PG8_LDB(B0, 0, 0); PG8_SCHED; PG8_LDA(At, 0, 0); PG8_STAGE(PG8_SA(1, 1), a1 + hstep, voffA);
            PG8_WAIT_L(8); PG8_BAR; PG8_WAIT_L(0); PG8_MMA(0, 0, At, B0); PG8_BAR; PG8_SCHED;
            PG8_LDB(B1, 0, 1); PG8_STAGE(PG8_SB(0, 0), b2, voffB);
            PG8_BAR; PG8_WAIT_L(0); PG8_MMA(0, 1, At, B1); PG8_BAR;
            PG8_LDA(At, 0, 1); PG8_STAGE(PG8_SA(0, 0), a2, voffA);
            PG8_BAR; PG8_WAIT_L(0); PG8_MMA(1, 0, At, B0); PG8_BAR; PG8_SCHED;
            PG8_STAGE(PG8_SB(0, 1), b2 + hstep, voffB);
            PG8_WAIT_V(6); PG8_BAR; PG8_MMA(1, 1, At, B1); PG8_BAR;
            PG8_LDB(B0, 1, 0); PG8_SCHED; PG8_LDA(At, 1, 0); PG8_STAGE(PG8_SA(0, 1), a2 + hstep, voffA);
            PG8_WAIT_L(8); PG8_BAR; PG8_WAIT_L(0); PG8_MMA(0, 0, At, B0); PG8_BAR; PG8_SCHED;
            PG8_LDB(B1, 1, 1); PG8_STAGE(PG8_SB(1, 0), b3, voffB);
            PG8_BAR; PG8_WAIT_L(0); PG8_MMA(0, 1, At, B1); PG8_BAR;
            PG8_LDA(At, 1, 1); PG8_STAGE(PG8_SA(1, 0), a3, voffA);
            PG8_BAR; PG8_WAIT_L(0); PG8_MMA(1, 0, At, B0); PG8_BAR; PG8_SCHED;
            PG8_STAGE(PG8_SB(1, 1), b3 + hstep, voffB);
            PG8_WAIT_V(6); PG8_BAR; PG8_MMA(1, 1, At, B1); PG8_BAR;
        }
        PG8_STAMP();
        if constexpr (!Epi::AFTER_DRAIN) { E(acc, cur, wr, wc, fr, fq); S.done(cur); }
        PG8_STAMP();
        if (!has_next) break;
#pragma unroll
        for (int a = 0; a < 2; ++a)
#pragma unroll
            for (int b = 0; b < 2; ++b)
#pragma unroll
                for (int m = 0; m < 4; ++m)
#pragma unroll
                    for (int n = 0; n < 2; ++n) acc[a][b][m][n] = (f32x4){0.f, 0.f, 0.f, 0.f};
        cur = nxt; cA = nA; cB = nB; ++ui;
    }
    PG8_WAIT_V(0);
    if (wr == 0) PG8_BAR;
    PG8_BAR;
    if constexpr (Epi::AFTER_DRAIN) { E.fused(acc, cur, wr, wc, fr, fq, lds, wid, lane); S.done(cur); }
    PG8_STAMP();
    if (STAMP && wid == 0) { stamps[lane] = lane < nts ? (((unsigned long long)(unsigned)ts_hi << 32) | (unsigned)ts_lo) : 0ull;
        if (lane == 62) stamps[62] = rt_entry; if (lane == 63) stamps[63] = (unsigned long long)wall_clock64(); }
#undef PG8_STAMP
#undef PG8_SA
#undef PG8_SB
#undef PG8_STAGE
#undef PG8_LDA
#undef PG8_LDB
#undef PG8_MMA
#undef PG8_WAIT_V
#undef PG8_WAIT_L
#undef PG8_BAR
#undef PG8_SCHED
}
}

namespace mk {
using pg8::bf16_t; using pg8::bf16x8; using pg8::f32x4; using pg8::u32x4; using pg8::cvt_pk_bf16;
typedef unsigned u32x2 __attribute__((ext_vector_type(2)));
constexpr int T = 24576, TP = 16384, SS = 2048, DM = 4096, NIN = 9216, DFF = 11008, NGU = 2 * DFF;
constexpr float ALPHA = 1.4142135623730951f;
constexpr float SC2 = 0.08838834764831845f * 1.4426950408889634f;
constexpr size_t OFF_BAR = 0, OFF_WIN = 16384, SZ_WIN = (size_t)2 * NIN * DM * 2, OFF_WOUT = OFF_WIN + SZ_WIN, SZ_WOUT = (size_t)2 * DM * DM * 2,
    OFF_WGU = OFF_WOUT + SZ_WOUT, SZ_WGU = (size_t)2 * NGU * DM * 2, OFF_WD = OFF_WGU + SZ_WGU, SZ_WD = (size_t)2 * DM * DFF * 2,
    OFF_XB = OFF_WD + SZ_WD, SZ_XB = (size_t)T * DM * 2, OFF_VT = OFF_XB + SZ_XB, SZ_VT = (size_t)20 * 128 * T * 2,
    OFF_PROJ = OFF_VT + SZ_VT, SZ_PROJ = (size_t)T * NIN * 2, OFF_MIX = OFF_PROJ + SZ_PROJ, SZ_MIX = (size_t)T * DM * 2, OFF_HDN = OFF_PROJ,
    WS_NEED = OFF_MIX + SZ_MIX;
static_assert((size_t)T * DFF * 2 <= SZ_PROJ + SZ_MIX, "hdn alias");

struct Params { const float* in[15]; float* out; unsigned char* ws; };

__device__ __forceinline__ float bf_lo(unsigned w) { return __uint_as_float(w << 16); }
__device__ __forceinline__ float bf_hi(unsigned w) { return __uint_as_float(w & 0xffff0000u); }

struct EpiResid {
    static constexpr bool PERM = false, AFTER_DRAIN = false;
    float* C; int ldc;
    __device__ __forceinline__ void operator()(const f32x4 (&acc)[2][2][4][2], const pg8::Unit& u, int wr, int wc, int fr, int fq) const {
        const int row0 = u.pm * 256 + wr * 64 + fr, col0 = u.pn * 256 + wc * 32 + 4 * fq;
#pragma unroll
        for (int ai = 0; ai < 2; ++ai)
#pragma unroll
            for (int m = 0; m < 4; ++m) { float* rowp = C + (size_t)(row0 + ai * 128 + m * 16) * ldc + col0;
#pragma unroll
                for (int bj = 0; bj < 2; ++bj)
#pragma unroll
                    for (int n = 0; n < 2; ++n) { f32x4 o = *(const f32x4*)(rowp + bj * 128 + n * 16); o = o * ALPHA + acc[ai][bj][m][n]; *(f32x4*)(rowp + bj * 128 + n * 16) = o; } }
    }
};
struct EpiSwiglu {
    static constexpr bool PERM = true, AFTER_DRAIN = false;
    bf16_t* O; int ldc;
    __device__ __forceinline__ void operator()(const f32x4 (&acc)[2][2][4][2], const pg8::Unit& u, int wr, int wc, int fr, int fq) const {
        const int row0 = u.pm * 256 + wr * 64 + fr, col0 = u.pn * 128 + wc * 32 + 8 * fq;
#pragma unroll
        for (int ai = 0; ai < 2; ++ai)
#pragma unroll
            for (int m = 0; m < 4; ++m) { bf16_t* rowp = O + (size_t)(row0 + ai * 128 + m * 16) * ldc + col0;
                float h[8];
#pragma unroll
                for (int n = 0; n < 2; ++n)
#pragma unroll
                    for (int e = 0; e < 4; ++e) { const float g = acc[ai][0][m][n][e], up = acc[ai][1][m][n][e]; h[n * 4 + e] = g * up * __builtin_amdgcn_rcpf(1.0f + __expf(-g)); }
                u32x4 w; w.x = cvt_pk_bf16(h[0], h[1]); w.y = cvt_pk_bf16(h[2], h[3]); w.z = cvt_pk_bf16(h[4], h[5]); w.w = cvt_pk_bf16(h[6], h[7]);
                *(u32x4*)rowp = w; }
    }
};

__device__ __forceinline__ void wt_phase(LAS unsigned char* lds, const Params& p) {
    LAS float* tile = (LAS float*)lds;
    const int tid = pg8::otid();
    for (int mi = 0; mi < 10; ++mi) {
        const int l = mi / 5, kind = mi % 5;
        const float* src; bf16_t* dst; int K, N, mode = 0;
        if (kind == 0)      { K = DM;  N = NIN; src = p.in[2]  + (size_t)l * K * N; dst = (bf16_t*)(p.ws + OFF_WIN)  + (size_t)l * NIN * DM; }
        else if (kind == 1) { K = DM;  N = DM;  src = p.in[7]  + (size_t)l * K * N; dst = (bf16_t*)(p.ws + OFF_WOUT) + (size_t)l * DM * DM; }
        else if (kind == 2) { K = DM;  N = DFF; src = p.in[10] + (size_t)l * K * N; dst = (bf16_t*)(p.ws + OFF_WGU)  + (size_t)l * NGU * DM; mode = 1; }
        else if (kind == 3) { K = DM;  N = DFF; src = p.in[11] + (size_t)l * K * N; dst = (bf16_t*)(p.ws + OFF_WGU)  + (size_t)l * NGU * DM; mode = 2; }
        else                { K = DFF; N = DM;  src = p.in[12] + (size_t)l * K * N; dst = (bf16_t*)(p.ws + OFF_WD)   + (size_t)l * DM * DFF; }
        const int nkt = K / 64, nst = nkt * (N / 256), G = (int)gridDim.x;
        int t = pg8::obid(); bool have = t < nst;
        f32x4 v[8];
        if (have) { const int k0 = (t % nkt) * 64, n0 = (t / nkt) * 256;
#pragma unroll
            for (int h = 0; h < 8; ++h) { const int idx = tid + 512 * h; v[h] = *(const f32x4*)(src + (size_t)(k0 + (idx >> 6)) * N + n0 + (idx & 63) * 4); } }
        while (have) {
            const int k0 = (t % nkt) * 64, n0 = (t / nkt) * 256;
#pragma unroll
            for (int h = 0; h < 8; ++h) { const int idx = tid + 512 * h; LAS float* d = tile + (idx >> 6) * 257 + (idx & 63) * 4; d[0] = v[h][0]; d[1] = v[h][1]; d[2] = v[h][2]; d[3] = v[h][3]; }
            __syncthreads();
            const int tn = t + G; const bool have_n = tn < nst;
            if (have_n) { const int k1 = (tn % nkt) * 64, n1 = (tn / nkt) * 256;
#pragma unroll
                for (int h = 0; h < 8; ++h) { const int idx = tid + 512 * h; v[h] = *(const f32x4*)(src + (size_t)(k1 + (idx >> 6)) * N + n1 + (idx & 63) * 4); } }
#pragma unroll
            for (int h = 0; h < 4; ++h) { const int idx = tid + 512 * h, nl = idx >> 3, k8 = (idx & 7) * 8, n = n0 + nl;
                const int drow = mode == 0 ? n : ((n >> 7) * 256 + (n & 127) + (mode == 2 ? 128 : 0));
                float f[8];
#pragma unroll
                for (int e = 0; e < 8; ++e) f[e] = tile[(k8 + e) * 257 + nl];
                u32x4 w; w.x = cvt_pk_bf16(f[0], f[1]); w.y = cvt_pk_bf16(f[2], f[3]); w.z = cvt_pk_bf16(f[4], f[5]); w.w = cvt_pk_bf16(f[6], f[7]);
                *(u32x4*)(dst + (size_t)drow * K + k0 + k8) = w; }
            __syncthreads();
            t = tn; have = have_n;
        }
    }
}
__device__ __forceinline__ void xin_phase(const Params& p) {
    bf16_t* xb = (bf16_t*)(p.ws + OFF_XB);
    const size_t n4 = (size_t)T * DM / 4, np4 = (size_t)TP * DM / 4;
    for (size_t i = (size_t)pg8::obid() * 512 + pg8::otid(); i < n4; i += (size_t)gridDim.x * 512) {
        const f32x4 v = i < np4 ? ((const f32x4*)p.in[0])[i] : ((const f32x4*)p.in[1])[i - np4];
        ((f32x4*)p.out)[i] = v;
        u32x2 w; w.x = cvt_pk_bf16(v[0], v[1]); w.y = cvt_pk_bf16(v[2], v[3]); ((u32x2*)xb)[i] = w;
    }
}

__device__ __forceinline__ void prep_phase(LAS unsigned char* lds, const Params& p, int layer) {
    bf16_t* proj = (bf16_t*)(p.ws + OFF_PROJ);
    const int tid = pg8::otid(), j = tid & 15; const int bid = pg8::obid();
    const float* gq = p.in[3] + layer * 128; const float* gk = p.in[4] + layer * 128;
    double invA[8], invB[8];
#pragma unroll
    for (int e = 0; e < 8; ++e) { invA[e] = exp2(-(double)(8 * (j & 1) + e) * (18.931568569324174 / 16.0)) * 0.15915494309189535;
                                  invB[e] = exp2(-(double)(8 * (j & 3) + e) * (13.287712379549449 / 32.0)) * 0.15915494309189535; }
    for (int v = (bid * 512 + tid) >> 4; v < T * 36; v += gridDim.x * 32) {
        const int tok = v / 36, hv = v - tok * 36; const bool isB = hv >= 16;
        const int col = isB ? 3072 + (hv - 16) * 128 : hv * 128;
        bf16_t* ptr = proj + (size_t)tok * NIN + col + j * 8;
        const u32x4 raw = *(const u32x4*)ptr;
        float x[8] = {bf_lo(raw.x), bf_hi(raw.x), bf_lo(raw.y), bf_hi(raw.y), bf_lo(raw.z), bf_hi(raw.z), bf_lo(raw.w), bf_hi(raw.w)};
        float ss = 0.f;
#pragma unroll
        for (int e = 0; e < 8; ++e) ss += x[e] * x[e];
        ss += __shfl_xor(ss, 1); ss += __shfl_xor(ss, 2); ss += __shfl_xor(ss, 4); ss += __shfl_xor(ss, 8);
        const float r = rsqrtf(ss * (1.0f / 128.0f) + 1e-6f);
        const float* gp = (hv - 16 < 16) ? gq : gk;
        const int t = tok < TP ? tok : ((tok - TP) & (SS - 1));
        const bool act = isB || j < 4;
        const bool first = isB ? !(j & 4) : !(j & 2);
        const int ib = isB ? 8 * (j & 3) : 8 * (j & 1);
        const int pos = isB ? (j < 8 ? (t >> 6) : (t & 63)) : t;
        const double lf = isB ? (13.287712379549449 / 32.0) : (18.931568569324174 / 16.0);
#pragma unroll
        for (int e = 0; e < 8; ++e) {
            if (isB) x[e] = x[e] * r * gp[j * 8 + e];
        }
        float o[8];
#pragma unroll
        for (int e = 0; e < 8; ++e) {
            const float pa = __shfl_xor(x[e], 2), pb = __shfl_xor(x[e], 4);
            const float pr = isB ? pb : pa;
            double rev = (double)pos * (isB ? invB[e] : invA[e]); rev -= floor(rev);
            const float fr = (float)rev;
            const float cs = __builtin_amdgcn_cosf(fr), sn = __builtin_amdgcn_sinf(fr);
            const float rot = first ? (x[e] * cs - pr * sn) : (x[e] * cs + pr * sn);
            o[e] = act ? rot : x[e];
        }
        u32x4 w; w.x = cvt_pk_bf16(o[0], o[1]); w.y = cvt_pk_bf16(o[2], o[3]); w.z = cvt_pk_bf16(o[4], o[5]); w.w = cvt_pk_bf16(o[6], o[7]);
        *(u32x4*)ptr = w;
    }
    bf16_t* vtg = (bf16_t*)(p.ws + OFF_VT);
    LAS bf16_t* vt = (LAS bf16_t*)lds;
    for (int tl = bid; tl < (T / 64) * 20; tl += gridDim.x) {
        const int tb = tl / 20, hh = tl - tb * 20;
        const int vcol = hh < 8 ? 2048 + hh * 128 : (hh < 12 ? 5632 + (hh - 8) * 128 : 8192 + (hh - 12) * 128);
#pragma unroll
        for (int h = 0; h < 2; ++h) { const int ch = tid + 512 * h, tokl = ch >> 4, part = ch & 15;
            const u32x4 raw = *(const u32x4*)(proj + (size_t)(tb * 64 + tokl) * NIN + vcol + part * 8);
            LAS unsigned* d = (LAS unsigned*)(vt + tokl * 130 + part * 8);
            d[0] = raw.x; d[1] = raw.y; d[2] = raw.z; d[3] = raw.w; }
        __syncthreads();
#pragma unroll
        for (int h = 0; h < 2; ++h) { const int ch = tid + 512 * h, d = ch & 127, tp = ch >> 7;
            unsigned short s[8];
#pragma unroll
            for (int e = 0; e < 8; ++e) s[e] = vt[(tp * 8 + e) * 130 + d];
            u32x4 w; w.x = s[0] | ((unsigned)s[1] << 16); w.y = s[2] | ((unsigned)s[3] << 16); w.z = s[4] | ((unsigned)s[5] << 16); w.w = s[6] | ((unsigned)s[7] << 16);
            *(u32x4*)(vtg + (size_t)(hh * 128 + d) * T + tb * 64 + tp * 8) = w; }
        __syncthreads();
    }
}

__device__ __forceinline__ float rowmax4(float v) {
    const unsigned a = __float_as_uint(v); const auto r = __builtin_amdgcn_permlane16_swap(a, a, false, false);
    const float m = fmaxf(__uint_as_float(r[0]), __uint_as_float(r[1]));
    const unsigned b = __float_as_uint(m); const auto q = __builtin_amdgcn_permlane32_swap(b, b, false, false);
    return fmaxf(__uint_as_float(q[0]), __uint_as_float(q[1])); }
__device__ __forceinline__ float rowsum4(float v) {
    const unsigned a = __float_as_uint(v); const auto r = __builtin_amdgcn_permlane16_swap(a, a, false, false);
    const float m = __uint_as_float(r[0]) + __uint_as_float(r[1]);
    const unsigned b = __float_as_uint(m); const auto q = __builtin_amdgcn_permlane32_swap(b, b, false, false);
    return __uint_as_float(q[0]) + __uint_as_float(q[1]); }
template <int MODE, int QT>
__device__ __forceinline__ void attn_item(LAS unsigned char* lds, const bf16_t* proj, const bf16_t* vtg, bf16_t* mixed, const float* rpb,
                                          int tok0, int bstart, int s, int head) {
    const int tid = pg8::otid(), w = tid >> 6, lane = tid & 63, c = lane & 15, g = lane >> 4;
    const int t0 = tok0 - bstart;
    int qcol, kcol, vhead, mcol, kb_lo, kb_hi, kbase;
    if (MODE == 0) { qcol = head * 128; kcol = 1024 + head * 128; vhead = head; mcol = head * 128; kbase = t0 - 1024;
        kb_lo = t0 >= 1024 ? 0 : (1024 - t0) >> 6; const int hi = (s - kbase) >> 6; kb_hi = hi < 36 ? hi : 36; }
    else if (MODE == 1) { qcol = 3072 + head * 128; kcol = 5120 + (head >> 2) * 128; vhead = 8 + (head >> 2); mcol = 1024 + head * 128; kbase = 0; kb_lo = 0; kb_hi = s >> 6; }
    else { qcol = 6144 + head * 128; kcol = 7168 + head * 128; vhead = 12 + head; mcol = 3072 + head * 128;
        const int rows = s >> 6, i0 = t0 >> 6; int rlo = i0 - 4; rlo = rlo < 0 ? 0 : (rlo > rows - 8 ? rows - 8 : rlo); int r1 = i0 - 3; r1 = r1 < 0 ? 0 : (r1 > rows - 8 ? rows - 8 : r1);
        kbase = rlo * 64; kb_lo = 0; kb_hi = r1 + 8 - rlo; }
    bf16x8 qf[QT][4];
#pragma unroll
    for (int qt = 0; qt < QT; ++qt)
#pragma unroll
        for (int ks = 0; ks < 4; ++ks) qf[qt][ks] = *(const bf16x8*)(proj + (size_t)(tok0 + (w * QT + qt) * 16 + c) * NIN + qcol + ks * 32 + g * 8);
    f32x4 oacc[QT][8]; float mrun[QT], lsum[QT];
#pragma unroll
    for (int qt = 0; qt < QT; ++qt) { mrun[qt] = -1e30f; lsum[qt] = 0.f;
#pragma unroll
        for (int dg = 0; dg < 8; ++dg) oacc[qt][dg] = (f32x4){0.f, 0.f, 0.f, 0.f}; }
    const int kkey = tid >> 4, kpart = tid & 15;
    const int vd = tid >> 3, vpart = tid & 7;
    const bf16_t* kg0 = proj + (long)(bstart + kbase + kkey) * NIN + kcol + kpart * 8;
    const bf16_t* vg0 = vtg + (long)(vhead * 128 + vd) * T + (long)(bstart + kbase + vpart * 8);
    u32x4 rk0, rk1, rv0, rv1;
#define MK_LOADREGS(kbx) do { const long ko_ = (long)(kbx) * 64 * NIN, vo_ = (long)(kbx) * 64; rk0 = *(const u32x4*)(kg0 + ko_); rk1 = *(const u32x4*)(kg0 + ko_ + (long)32 * NIN); \
        rv0 = *(const u32x4*)(vg0 + vo_); rv1 = *(const u32x4*)(vg0 + vo_ + (long)64 * T); } while (0)
#define MK_WRITEREGS(b) do { LAS unsigned char* Kw = lds + (b) * 35840; LAS unsigned char* Vw = Kw + 17408; \
        *(LAS u32x4*)(Kw + (kkey * 136 + kpart * 8) * 2) = rk0; *(LAS u32x4*)(Kw + ((kkey + 32) * 136 + kpart * 8) * 2) = rk1; \
        { const int vpos = (vpart >> 2) * 32 + (vpart & 1) * 16 + ((vpart & 3) >> 1) * 4; \
          LAS unsigned char* v0 = Vw + (vd * 72 + vpos) * 2; LAS unsigned char* v1 = Vw + ((vd + 64) * 72 + vpos) * 2; \
          u32x2 t_; t_.x = rv0.x; t_.y = rv0.y; *(LAS u32x2*)v0 = t_; t_.x = rv0.z; t_.y = rv0.w; *(LAS u32x2*)(v0 + 16) = t_; \
          t_.x = rv1.x; t_.y = rv1.y; *(LAS u32x2*)v1 = t_; t_.x = rv1.z; t_.y = rv1.w; *(LAS u32x2*)(v1 + 16) = t_; } } while (0)
    __syncthreads();
    MK_LOADREGS(kb_lo);
    MK_WRITEREGS(0);
    if (kb_lo + 1 < kb_hi) MK_LOADREGS(kb_lo + 1);
    int cur = 0;
    for (int kb = kb_lo; kb < kb_hi; ++kb) {
        __syncthreads();
        if (kb + 1 < kb_hi) MK_WRITEREGS(cur ^ 1);
        if (kb + 2 < kb_hi) MK_LOADREGS(kb + 2);
        const LAS unsigned char* Ks = lds + cur * 35840; const LAS unsigned char* Vs = Ks + 17408; cur ^= 1;
        f32x4 sacc[QT][4];
#pragma unroll
        for (int qt = 0; qt < QT; ++qt)
#pragma unroll
            for (int kg = 0; kg < 4; ++kg) sacc[qt][kg] = (f32x4){0.f, 0.f, 0.f, 0.f};
        { const LAS unsigned char* kb_ = Ks + (c * 136 + g * 8) * 2;
          bf16x8 kf[4][4];
#pragma unroll
          for (int ks = 0; ks < 4; ++ks)
#pragma unroll
              for (int kg = 0; kg < 4; ++kg) kf[ks][kg] = *(const LAS bf16x8*)(kb_ + (kg * 16 * 136 + ks * 32) * 2);
#pragma unroll
          for (int ks = 0; ks < 4; ++ks)
#pragma unroll
              for (int kg = 0; kg < 4; ++kg)
#pragma unroll
                  for (int qt = 0; qt < QT; ++qt) sacc[qt][kg] = __builtin_amdgcn_mfma_f32_16x16x32_bf16(kf[ks][kg], qf[qt][ks], sacc[qt][kg], 0, 0, 0); }
        bf16x8 pf[QT][2];
#pragma unroll
        for (int qt = 0; qt < QT; ++qt) {
            const int qi = (w * QT + qt) * 16 + c;
            float pv[4][4];
            if constexpr (MODE == 1) {
                const f32x4 m4 = __builtin_elementwise_max(__builtin_elementwise_max(sacc[qt][0], sacc[qt][1]), __builtin_elementwise_max(sacc[qt][2], sacc[qt][3]));
                float mx = fmaxf(fmaxf(m4[0], m4[1]), fmaxf(m4[2], m4[3])) * SC2;
                mx = rowmax4(mx);
                const float mnew = fmaxf(mrun[qt], mx), alpha = __builtin_amdgcn_exp2f(mrun[qt] - mnew); mrun[qt] = mnew;
                f32x4 ps4 = (f32x4){0.f, 0.f, 0.f, 0.f};
#pragma unroll
                for (int kg = 0; kg < 4; ++kg) { const f32x4 tt = sacc[qt][kg] * SC2 - mnew;
                    f32x4 pe; pe[0] = __builtin_amdgcn_exp2f(tt[0]); pe[1] = __builtin_amdgcn_exp2f(tt[1]); pe[2] = __builtin_amdgcn_exp2f(tt[2]); pe[3] = __builtin_amdgcn_exp2f(tt[3]);
                    ps4 += pe; pv[kg][0] = pe[0]; pv[kg][1] = pe[1]; pv[kg][2] = pe[2]; pv[kg][3] = pe[3]; }
                lsum[qt] = lsum[qt] * alpha + ((ps4[0] + ps4[1]) + (ps4[2] + ps4[3]));
#pragma unroll
                for (int dg = 0; dg < 8; ++dg) oacc[qt][dg] *= alpha;
            } else {
            float x[4][4]; bool ok[4][4]; float mx = -1e30f;
#pragma unroll
            for (int kg = 0; kg < 4; ++kg)
#pragma unroll
                for (int e = 0; e < 4; ++e) { const int jk = kg * 16 + g * 4 + e; float v = sacc[qt][kg][e] * SC2; bool valid = true;
                    if (MODE == 0) { const int dl = 64 * kb + jk - qi - 1024, ad = dl < 0 ? -dl : dl;
                        const int mult = (ad <= 64 ? 1 : 0) + (((dl & 3) == 0 && ad <= 256) ? 1 : 0) + (((dl & 15) == 0 && ad <= 1024) ? 1 : 0);
                        valid = mult > 0; v += mult == 3 ? 1.5849625007211562f : (mult == 2 ? 1.0f : 0.0f); }
                    if (MODE == 2) { const int rows = s >> 6, ri = (t0 >> 6) + (qi >> 6), qc = qi & 63, rk = (kbase >> 6) + kb;
                        int rs = ri - 4; rs = rs < 0 ? 0 : (rs > rows - 8 ? rows - 8 : rs); int cst = qc - 8; cst = cst < 0 ? 0 : (cst > 48 ? 48 : cst);
                        valid = rk >= rs && rk < rs + 8 && jk >= cst && jk < cst + 16;
                        if (valid) v += rpb[head * 465 + (rk - ri + 7) * 31 + (jk - qc + 15)] * 1.4426950408889634f; }
                    x[kg][e] = v; ok[kg][e] = valid; mx = valid ? fmaxf(mx, v) : mx; }
            mx = rowmax4(mx);
            const float mnew = fmaxf(mrun[qt], mx), alpha = __builtin_amdgcn_exp2f(mrun[qt] - mnew); mrun[qt] = mnew; lsum[qt] *= alpha;
#pragma unroll
            for (int dg = 0; dg < 8; ++dg) oacc[qt][dg] *= alpha;
            float ps = 0.f;
#pragma unroll
            for (int kg = 0; kg < 4; ++kg)
#pragma unroll
                for (int e = 0; e < 4; ++e) { const float pe = ok[kg][e] ? __builtin_amdgcn_exp2f(x[kg][e] - mnew) : 0.f; pv[kg][e] = pe; ps += pe; }
            lsum[qt] += ps;
            }
#pragma unroll
            for (int sI = 0; sI < 2; ++sI) { u32x4 pw; pw.x = cvt_pk_bf16(pv[2 * sI][0], pv[2 * sI][1]); pw.y = cvt_pk_bf16(pv[2 * sI][2], pv[2 * sI][3]);
                pw.z = cvt_pk_bf16(pv[2 * sI + 1][0], pv[2 * sI + 1][1]); pw.w = cvt_pk_bf16(pv[2 * sI + 1][2], pv[2 * sI + 1][3]);
                pf[qt][sI] = __builtin_bit_cast(bf16x8, pw); }
        }
        { const LAS unsigned char* vb = Vs + (c * 72 + g * 8) * 2;
          bf16x8 vf0[8], vf1[8];
#pragma unroll
          for (int dg = 0; dg < 8; ++dg) vf0[dg] = *(const LAS bf16x8*)(vb + (dg * 16 * 72) * 2);
#pragma unroll
          for (int dg = 0; dg < 8; ++dg) vf1[dg] = *(const LAS bf16x8*)(vb + (dg * 16 * 72 + 32) * 2);
#pragma unroll
          for (int dg = 0; dg < 8; ++dg)
#pragma unroll
              for (int qt = 0; qt < QT; ++qt) oacc[qt][dg] = __builtin_amdgcn_mfma_f32_16x16x32_bf16(vf0[dg], pf[qt][0], oacc[qt][dg], 0, 0, 0);
#pragma unroll
          for (int dg = 0; dg < 8; ++dg)
#pragma unroll
              for (int qt = 0; qt < QT; ++qt) oacc[qt][dg] = __builtin_amdgcn_mfma_f32_16x16x32_bf16(vf1[dg], pf[qt][1], oacc[qt][dg], 0, 0, 0); }
    }
#undef MK_LOADREGS
#undef MK_WRITEREGS
#pragma unroll
    for (int qt = 0; qt < QT; ++qt) {
        const float l = rowsum4(lsum[qt]);
        const float inv = 1.0f / l;
        bf16_t* op = mixed + (size_t)(tok0 + (w * QT + qt) * 16 + c) * DM + mcol + g * 4;
#pragma unroll
        for (int dg = 0; dg < 8; ++dg) { const f32x4 o = oacc[qt][dg] * inv; u32x2 ow; ow.x = cvt_pk_bf16(o[0], o[1]); ow.y = cvt_pk_bf16(o[2], o[3]); *(u32x2*)(op + dg * 16) = ow; }
    }
}

__device__ __forceinline__ void attn_phase(LAS unsigned char* lds, const Params& p, int layer) {
    const bf16_t* proj = (const bf16_t*)(p.ws + OFF_PROJ); const bf16_t* vtg = (const bf16_t*)(p.ws + OFF_VT); bf16_t* mixed = (bf16_t*)(p.ws + OFF_MIX);
    const float* rpb = p.in[5] + layer * (8 * 15 * 31);
    for (int it = pg8::obid(); it < 1024; it += gridDim.x) { const int head = it & 15, qb = it >> 4; attn_item<1, 2>(lds, proj, vtg, mixed, rpb, qb * 256, 0, TP, head); }
    for (int it = pg8::obid(); it < 512; it += gridDim.x) { const int head = it & 15, qb = it >> 4; attn_item<1, 2>(lds, proj, vtg, mixed, rpb, TP + qb * 256, TP + (qb >> 3) * SS, SS, head); }
    for (int it = pg8::obid(); it < 1536; it += gridDim.x) { const int head = it & 7, tok0 = (it >> 3) * 128; const bool pr = tok0 < TP; const int bs = pr ? 0 : TP + ((tok0 - TP) / SS) * SS;
        attn_item<0, 1>(lds, proj, vtg, mixed, rpb, tok0, bs, pr ? TP : SS, head); }
    for (int it = pg8::obid(); it < 1536; it += gridDim.x) { const int head = it & 7, tok0 = (it >> 3) * 128; const bool pr = tok0 < TP; const int bs = pr ? 0 : TP + ((tok0 - TP) / SS) * SS;
        attn_item<2, 1>(lds, proj, vtg, mixed, rpb, tok0, bs, pr ? TP : SS, head); }
}

__device__ __forceinline__ void grms_phase(const Params& p, int layer) {
    bf16_t* mixed = (bf16_t*)(p.ws + OFF_MIX); const float* gg = p.in[6] + layer * DM;
    const int tid0 = pg8::otid(), lane = tid0 & 63, wv = tid0 >> 6; const int bid = pg8::obid();
    for (int tok = bid * 8 + wv; tok < T; tok += gridDim.x * 8) {
        bf16_t* row = mixed + (size_t)tok * DM;
        u32x4 raw[8]; float ssq[3] = {0.f, 0.f, 0.f};
#pragma unroll
        for (int k = 0; k < 8; ++k) { raw[k] = *(const u32x4*)(row + (lane + 64 * k) * 8);
            const float a0 = bf_lo(raw[k].x), a1 = bf_hi(raw[k].x), a2 = bf_lo(raw[k].y), a3 = bf_hi(raw[k].y), a4 = bf_lo(raw[k].z), a5 = bf_hi(raw[k].z), a6 = bf_lo(raw[k].w), a7 = bf_hi(raw[k].w);
            const float q = a0 * a0 + a1 * a1 + a2 * a2 + a3 * a3 + a4 * a4 + a5 * a5 + a6 * a6 + a7 * a7;
            ssq[k < 2 ? 0 : (k < 6 ? 1 : 2)] += q; }
        float sc[3];
#pragma unroll
        for (int gI = 0; gI < 3; ++gI) { float v = ssq[gI];
#pragma unroll
            for (int o = 32; o >= 1; o >>= 1) v += __shfl_xor(v, o);
            sc[gI] = rsqrtf(v / (gI == 1 ? 2048.0f : 1024.0f) + 1e-6f); }
#pragma unroll
        for (int k = 0; k < 8; ++k) { const float r = sc[k < 2 ? 0 : (k < 6 ? 1 : 2)]; const int col = (lane + 64 * k) * 8;
            const f32x4 g0 = *(const f32x4*)(gg + col), g1 = *(const f32x4*)(gg + col + 4);
            u32x4 w; w.x = cvt_pk_bf16(bf_lo(raw[k].x) * r * g0[0], bf_hi(raw[k].x) * r * g0[1]); w.y = cvt_pk_bf16(bf_lo(raw[k].y) * r * g0[2], bf_hi(raw[k].y) * r * g0[3]);
            w.z = cvt_pk_bf16(bf_lo(raw[k].z) * r * g1[0], bf_hi(raw[k].z) * r * g1[1]); w.w = cvt_pk_bf16(bf_lo(raw[k].w) * r * g1[2], bf_hi(raw[k].w) * r * g1[3]);
            *(u32x4*)(row + col) = w; }
    }
}
__device__ __forceinline__ void ln_phase(const Params& p, const float* gam, const float* bet) {
    bf16_t* xb = (bf16_t*)(p.ws + OFF_XB);
    const int tid0 = pg8::otid(), lane = tid0 & 63, wv = tid0 >> 6; const int bid = pg8::obid();
    for (int tok = bid * 8 + wv; tok < T; tok += gridDim.x * 8) {
        float* row = p.out + (size_t)tok * DM;
        f32x4 v[16]; float s = 0.f;
#pragma unroll
        for (int k = 0; k < 16; ++k) { v[k] = *(const f32x4*)(row + (lane + 64 * k) * 4); s += (v[k][0] + v[k][1]) + (v[k][2] + v[k][3]); }
#pragma unroll
        for (int o = 32; o >= 1; o >>= 1) s += __shfl_xor(s, o);
        const float mean = s * (1.0f / DM); float q = 0.f;
#pragma unroll
        for (int k = 0; k < 16; ++k) { const f32x4 d = v[k] - mean; q += (d[0] * d[0] + d[1] * d[1]) + (d[2] * d[2] + d[3] * d[3]); }
#pragma unroll
        for (int o = 32; o >= 1; o >>= 1) q += __shfl_xor(q, o);
        const float rstd = rsqrtf(q * (1.0f / DM) + 1e-5f);
#pragma unroll
        for (int k = 0; k < 16; ++k) { const int col = (lane + 64 * k) * 4; const f32x4 gv = *(const f32x4*)(gam + col), bv = *(const f32x4*)(bet + col);
            const f32x4 o = (v[k] - mean) * rstd * gv + bv; *(f32x4*)(row + col) = o;
            u32x2 w; w.x = cvt_pk_bf16(o[0], o[1]); w.y = cvt_pk_bf16(o[2], o[3]); *(u32x2*)(xb + (size_t)tok * DM + col) = w; }
    }
}

__global__ __launch_bounds__(512, 2) void fwd(Params p) {
    extern __shared__ __attribute__((aligned(16))) unsigned char shm[];
    LAS unsigned char* lds = (LAS unsigned char*)shm;
    volatile LAS unsigned* xbw = (volatile LAS unsigned*)(lds + pg8::STAGE_BYTES);
    if (threadIdx.x < 4) xbw[threadIdx.x] = 0u;
    __syncthreads();
    XcdBarrier bar = xcd_barrier_post((unsigned*)(p.ws + OFF_BAR), xbw);
    const int G = (int)gridDim.x;
    wt_phase(lds, p);
    xin_phase(p);
    xcd_barrier(bar);
    bf16_t* xb = (bf16_t*)(p.ws + OFF_XB); bf16_t* proj = (bf16_t*)(p.ws + OFF_PROJ); bf16_t* mixed = (bf16_t*)(p.ws + OFF_MIX); bf16_t* hdn = (bf16_t*)(p.ws + OFF_HDN);
#pragma unroll 1
    for (int l = 0; l < 2; ++l) {
        { pg8::Gemm g{xb, (const bf16_t*)(p.ws + OFF_WIN) + (size_t)l * NIN * DM, T, NIN, DM}; pg8::StaticOrder S; S.init(T, NIN, G, pg8::obid());
          pg8::EpiBf16<0> E{proj, NIN, nullptr, 0, 0}; pg8::gemm_phase<pg8::EpiBf16<0>, pg8::StaticOrder, false>(lds, g, S, E, nullptr); }
        xcd_barrier(bar);
        prep_phase(lds, p, l);
        xcd_barrier(bar);
        attn_phase(lds, p, l);
        xcd_barrier(bar);
        grms_phase(p, l);
        xcd_barrier(bar);
        { pg8::Gemm g{mixed, (const bf16_t*)(p.ws + OFF_WOUT) + (size_t)l * DM * DM, T, DM, DM}; pg8::StaticOrder S; S.init(T, DM, G, pg8::obid());
          EpiResid E{p.out, DM}; pg8::gemm_phase<EpiResid, pg8::StaticOrder, false>(lds, g, S, E, nullptr); }
        xcd_barrier(bar);
        ln_phase(p, p.in[8] + l * DM, p.in[9] + l * DM);
        xcd_barrier(bar);
        { pg8::Gemm g{xb, (const bf16_t*)(p.ws + OFF_WGU) + (size_t)l * NGU * DM, T, NGU, DM}; pg8::StaticOrder S; S.init(T, NGU, G, pg8::obid());
          EpiSwiglu E{hdn, DFF}; pg8::gemm_phase<EpiSwiglu, pg8::StaticOrder, false>(lds, g, S, E, nullptr); }
        xcd_barrier(bar);
        { pg8::Gemm g{hdn, (const bf16_t*)(p.ws + OFF_WD) + (size_t)l * DM * DFF, T, DM, DFF}; pg8::StaticOrder S; S.init(T, DM, G, pg8::obid());
          EpiResid E{p.out, DM}; pg8::gemm_phase<EpiResid, pg8::StaticOrder, false>(lds, g, S, E, nullptr); }
        xcd_barrier(bar);
        ln_phase(p, p.in[13] + l * DM, p.in[14] + l * DM);
        xcd_barrier(bar);
    }
}
}

extern "C" void kernel_launch(void* const* d_in, const int* in_sizes, int n_in, void* d_out, int out_size, void* d_ws, size_t ws_size, hipStream_t stream) {
    constexpr int LDSB = pg8::STAGE_BYTES + 16;
    static int grid = 0;
    if (!grid) {
        int dev = 0, cus = 0, per_cu = 0;
        hipGetDevice(&dev);
        hipDeviceGetAttribute(&cus, hipDeviceAttributeMultiprocessorCount, dev);
        if (hipFuncSetAttribute((const void*)mk::fwd, hipFuncAttributeMaxDynamicSharedMemorySize, LDSB) != hipSuccess) { fprintf(stderr, "hipFuncSetAttribute failed\n"); grid = -1; }
        else if (hipOccupancyMaxActiveBlocksPerMultiprocessor(&per_cu, (const void*)mk::fwd, 512, LDSB) != hipSuccess || per_cu < 1) { fprintf(stderr, "occupancy query failed\n"); grid = -1; }
        else grid = cus;
    }
    if (grid <= 0 || ws_size < mk::WS_NEED || n_in < 15) { fprintf(stderr, "kernel_launch: refused (grid %d, ws %zu need %zu)\n", grid, ws_size, (size_t)mk::WS_NEED); return; }
    hipMemsetAsync((unsigned char*)d_ws + mk::OFF_BAR, 0, 16384, stream);
    mk::Params p{};
    for (int i = 0; i < 15; ++i) p.in[i] = (const float*)d_in[i];
    p.out = (float*)d_out; p.ws = (unsigned char*)d_ws;
    hipLaunchKernelGGL(mk::fwd, dim3(grid), dim3(512), LDSB, stream, p);
}
```

```cpp
#include <hip/hip_runtime.h>
#include <cstdio>
#include <cstdint>
#define XB_TMO      128
#define XB_XCNT(j)  (256  + 64 * (j))
#define XB_XSUB(j)  (1280 + 64 * (j))
#define XB_XGEN(j)  (2304 + 64 * (j))
#define XB_TOP      3328
#define XB_TOPGEN   3392
#define XCD_BAR_WORDS 3456
#define XB_SPIN_CAP (1u << 18)
#define LAS __attribute__((address_space(3)))

__device__ __forceinline__ unsigned xb_ld(unsigned* p)              { return __hip_atomic_load(p, __ATOMIC_RELAXED, __HIP_MEMORY_SCOPE_AGENT); }
__device__ __forceinline__ unsigned xb_add(unsigned* p, unsigned v) { return __hip_atomic_fetch_add(p, v, __ATOMIC_RELAXED, __HIP_MEMORY_SCOPE_AGENT); }
__device__ __forceinline__ unsigned xb_xcc_id() { return (unsigned)__builtin_amdgcn_s_getreg((3 << 11) | 20) & 0xFu; }
#define XB_SPIN(cond, bar) do { unsigned _sp = 0; while (cond) { __builtin_amdgcn_s_sleep(1); \
    if ((++_sp & 255u) == 0u) { if (xb_ld(&(bar)[XB_TMO])) break; if (_sp > XB_SPIN_CAP) { atomicAdd(&(bar)[XB_TMO], 1u); break; } } } } while (0)

struct XcdBarrier {
    unsigned* bar; unsigned x;
    volatile LAS unsigned* st;
};

__device__ __forceinline__ XcdBarrier xcd_barrier_post(unsigned* bar, volatile LAS unsigned* st) {
    XcdBarrier b; b.bar = bar; b.x = xb_xcc_id(); b.st = st;
    if (threadIdx.x == 0) (void)xb_add(&bar[XB_XCNT(b.x)], 1u);
    return b;
}
__device__ __forceinline__ void xcd_barrier_complete(unsigned* bar, unsigned x, unsigned& nloc, unsigned& nx) {
    const unsigned G = gridDim.x * gridDim.y * gridDim.z;
    unsigned sum, cnt, mine, sp = 0u;
    for (;;) {
        sum = 0u; cnt = 0u; mine = 0u;
#pragma unroll
        for (unsigned j = 0; j < 16; ++j) { const unsigned c = xb_ld(&bar[XB_XCNT(j)]); sum += c; cnt += (c > 0u) ? 1u : 0u; mine = (j == x) ? c : mine; }
        if (sum == G) break;
        __builtin_amdgcn_s_sleep(1);
        if ((++sp & 255u) == 0u) { if (xb_ld(&bar[XB_TMO])) break; if (sp > XB_SPIN_CAP) { atomicAdd(&bar[XB_TMO], 1u); break; } }
    }
    nloc = mine > 0u ? mine : 1u; nx = cnt > 0u ? cnt : 1u;
}

__device__ __forceinline__ void xcd_barrier(const XcdBarrier& b) {
    asm volatile("s_waitcnt vmcnt(0)" ::: "memory");
    __syncthreads();
    if (threadIdx.x == 0) {
        unsigned* bar = b.bar; unsigned bx = xb_xcc_id(); asm volatile("" : "+s"(bx));
        __builtin_amdgcn_s_waitcnt(0);
        unsigned nloc = b.st[0], nx = b.st[1];
        if (nloc == 0u) { xcd_barrier_complete(bar, bx, nloc, nx); b.st[0] = nloc; b.st[1] = nx; }
        const unsigned old = xb_add(&bar[XB_XSUB(bx)], 1u);
        const unsigned gen = old / nloc;
        if (old + 1u == (gen + 1u) * nloc) {
            __builtin_amdgcn_fence(__ATOMIC_RELEASE, "agent");
            asm volatile("s_waitcnt vmcnt(0)" ::: "memory");
            const unsigned og = xb_add(&bar[XB_TOP], 1u);
            const unsigned tg = og / nx;
            if (og + 1u == (tg + 1u) * nx) xb_add(&bar[XB_TOPGEN], 1u);
            else XB_SPIN(xb_ld(&bar[XB_TOPGEN]) == tg, bar);
            __builtin_amdgcn_fence(__ATOMIC_ACQUIRE, "agent");
            xb_add(&bar[XB_XGEN(bx)], 1u);
            asm volatile("s_waitcnt vmcnt(0)" ::: "memory");
        } else {
            XB_SPIN(xb_ld(&bar[XB_XGEN(bx)]) == gen, bar);
            __builtin_amdgcn_fence(__ATOMIC_ACQUIRE, "agent");
            asm volatile("s_waitcnt vmcnt(0)" ::: "memory");
        }
    }
    __syncthreads();
}
namespace pg8 {
__device__ __forceinline__ int otid() { int t = (int)threadIdx.x; asm volatile("" : "+v"(t)); return t; }
__device__ __forceinline__ int obid() { int b = (int)blockIdx.x; asm volatile("" : "+s"(b)); return b; }

#define PG8_LAS __attribute__((address_space(3)))
typedef unsigned short bf16_t;
typedef short bf16x8 __attribute__((ext_vector_type(8)));
typedef float f32x4 __attribute__((ext_vector_type(4)));
typedef unsigned u32x4 __attribute__((ext_vector_type(4)));
constexpr int BM = 256, BK = 64, HALF = 128, HTB = HALF * BK * 2  , STAGE_BYTES = 8 * HTB, NXCD = 8, WGM = 8;

__host__ __device__ __forceinline__ int lds_byte(int r, int c) { const int st = (r >> 4) * 2 + (c >> 5), rr = r & 15, cc = c & 31, ob = rr * 64 + cc * 2; return st * 1024 + (ob ^ (((ob >> 9) & 1) << 5)); }
__host__ __device__ __forceinline__ void stage_rc(int b, int& R, int& C) { const int st = b / 1024, sb = b % 1024, swz = sb ^ (((sb >> 9) & 1) << 5); R = (st >> 1) * 16 + swz / 64; C = (st & 1) * 32 + (swz % 64) / 2; }
__host__ __device__ __forceinline__ int perm32(int rho) { const int n = rho >> 4, i = rho & 15; return 8 * (i >> 2) + 4 * n + (i & 3); }

struct Unit { int pm, pn; };
struct Gemm { const bf16_t* A; const bf16_t* Bt; int M, N, K; };

struct StaticOrder {
    int nM, nN, nwg, G, c;
    __host__ __device__ void init(int M, int N, int G_, int c_) { nM = M / BM; nN = N / BM; nwg = nM * nN; G = G_; c = c_; }
    __host__ __device__ bool next(int i, Unit& u) const {
        const long L = (long)i * G + c; if (L >= nwg) return false;
        int wgid = (int)L; { const int q = nwg / NXCD, r = nwg % NXCD, xcd = wgid % NXCD, off = wgid / NXCD; wgid = (xcd < r ? xcd * (q + 1) : r * (q + 1) + (xcd - r) * q) + off; }
        const int nig = WGM * nN, gid = wgid / nig, fm = gid * WGM, gsz = (nM - fm) < WGM ? (nM - fm) : WGM;
        u.pm = fm + ((wgid % nig) % gsz); u.pn = (wgid % nig) / gsz; return true;
    }
    __device__ __forceinline__ void a_ready(const Unit&) const {}
    __device__ __forceinline__ void done(const Unit&) const {}
};
struct CountedOrder : StaticOrder {
    const unsigned* ready; unsigned need; unsigned* tmo;
    __device__ __forceinline__ void a_ready(const Unit& u) const {
        if (threadIdx.x < 64) {
            const unsigned long long t0 = __builtin_amdgcn_s_memrealtime(); unsigned polls = 0;
            while ((unsigned)__builtin_amdgcn_readfirstlane(__hip_atomic_load(ready + 64 * u.pm, __ATOMIC_RELAXED, __HIP_MEMORY_SCOPE_AGENT)) < need) {
                if ((++polls & 255u) == 0u && __builtin_amdgcn_readfirstlane(__hip_atomic_load(tmo, __ATOMIC_RELAXED, __HIP_MEMORY_SCOPE_AGENT)) != 0u) break;
                if (__builtin_amdgcn_s_memrealtime() - t0 > 2000000ull) {
                    if (threadIdx.x == 0) { unsigned expect = 0u; __hip_atomic_compare_exchange_strong(tmo + 1, &expect, 0x600u | (unsigned)(u.pm & 0xff), __ATOMIC_RELAXED, __ATOMIC_RELAXED, __HIP_MEMORY_SCOPE_AGENT); __hip_atomic_store(tmo, 1u, __ATOMIC_RELAXED, __HIP_MEMORY_SCOPE_AGENT); }
                    break; }
                __builtin_amdgcn_s_sleep(2); }
            __builtin_amdgcn_fence(__ATOMIC_ACQUIRE, "agent");
            asm volatile("s_waitcnt vmcnt(0)" ::: "memory");
        }
#if !defined(BROKEN_HOOK_NO_BARRIER)
        asm volatile("" ::: "memory"); __builtin_amdgcn_s_barrier(); asm volatile("" ::: "memory");
#endif
    }
};

__device__ __forceinline__ unsigned cvt_pk_bf16(float lo, float hi) { unsigned r; asm volatile("v_cvt_pk_bf16_f32 %0, %1, %2" : "=v"(r) : "v"(lo), "v"(hi)); return r; }
typedef float f32x2 __attribute__((ext_vector_type(2)));
__device__ __forceinline__ f32x2 gelu_pk(f32x2 v) {
    const f32x2 av = __builtin_elementwise_abs(v), d = av * 0.2316418882f + 1.0f;
    f32x2 t; t.x = __builtin_amdgcn_rcpf(d.x); t.y = __builtin_amdgcn_rcpf(d.y);
    f32x2 q = t * 0.5307027145f + (-0.7265760135f); q = q * t + 0.7107068705f; q = q * t + (-0.142248368f); q = q * t + 0.127414796f; q = q * t;
    const f32x2 s = (v * v) * (-0.72134752044f);
    f32x2 e; e.x = __builtin_amdgcn_exp2f(s.x); e.y = __builtin_amdgcn_exp2f(s.y);
    const f32x2 m = v * (q * e), r = v - m;
    f32x2 o; o.x = v.x < 0.f ? m.x : r.x; o.y = v.y < 0.f ? m.y : r.y; return o;
}

struct EpiF32 {
    static constexpr bool PERM = false, AFTER_DRAIN = false;
    float* C; int ldc; const float* bias;
    __device__ __forceinline__ void operator()(const f32x4 (&acc)[2][2][4][2], const Unit& u, int wr, int wc, int fr, int fq) const {
        const int row0 = u.pm * BM + wr * 64 + fr, col0 = u.pn * BM + wc * 32 + 4 * fq;
        f32x4 bv[2][2];
#pragma unroll
        for (int bj = 0; bj < 2; ++bj)
#pragma unroll
            for (int n = 0; n < 2; ++n) bv[bj][n] = bias ? *(const f32x4*)(bias + col0 + bj * HALF + n * 16) : (f32x4){0.f, 0.f, 0.f, 0.f};
#pragma unroll
        for (int ai = 0; ai < 2; ++ai)
#pragma unroll
            for (int m = 0; m < 4; ++m) { float* rowp = C + (size_t)(row0 + ai * HALF + m * 16) * ldc + col0;
#pragma unroll
                for (int bj = 0; bj < 2; ++bj)
#pragma unroll
                    for (int n = 0; n < 2; ++n) *(f32x4*)(rowp + bj * HALF + n * 16) = acc[ai][bj][m][n] + bv[bj][n]; }
    }
};
template <int ACT  > struct EpiBf16 {
    static constexpr bool PERM = true, AFTER_DRAIN = false;
    bf16_t* O; int ldc; const float* bias; int split_cols; size_t split_stride;
    __device__ __forceinline__ void operator()(const f32x4 (&acc)[2][2][4][2], const Unit& u, int wr, int wc, int fr, int fq) const {
        const int row0 = u.pm * BM + wr * 64 + fr; int colt = u.pn * BM; bf16_t* base = O;
        if (split_cols) { const int t = colt / split_cols; base += (size_t)t * split_stride; colt -= t * split_cols; }
        const int col0 = colt + wc * 32 + 8 * fq, bcol0 = u.pn * BM + wc * 32 + 8 * fq;
        f32x4 bv[2][2];
#pragma unroll
        for (int bj = 0; bj < 2; ++bj)
#pragma unroll
            for (int n = 0; n < 2; ++n) bv[bj][n] = bias ? *(const f32x4*)(bias + bcol0 + bj * HALF + 4 * n) : (f32x4){0.f, 0.f, 0.f, 0.f};
#pragma unroll
        for (int ai = 0; ai < 2; ++ai)
#pragma unroll
            for (int m = 0; m < 4; ++m) { bf16_t* rowp = base + (size_t)(row0 + ai * HALF + m * 16) * ldc + col0;
#pragma unroll
                for (int bj = 0; bj < 2; ++bj) { f32x4 v0 = acc[ai][bj][m][0] + bv[bj][0], v1 = acc[ai][bj][m][1] + bv[bj][1];
                    if (ACT == 1) { f32x2 a = gelu_pk((f32x2){v0[0], v0[1]}), b = gelu_pk((f32x2){v0[2], v0[3]}), c = gelu_pk((f32x2){v1[0], v1[1]}), d = gelu_pk((f32x2){v1[2], v1[3]});
                        v0 = (f32x4){a.x, a.y, b.x, b.y}; v1 = (f32x4){c.x, c.y, d.x, d.y}; }
                    if (ACT == 2) {
#pragma unroll
                        for (int j = 0; j < 4; ++j) { v0[j] = 0.5f * v0[j] * (1.0f + erff(v0[j] * 0.70710678f)); v1[j] = 0.5f * v1[j] * (1.0f + erff(v1[j] * 0.70710678f)); } }
                    u32x4 w; w.x = cvt_pk_bf16(v0[0], v0[1]); w.y = cvt_pk_bf16(v0[2], v0[3]); w.z = cvt_pk_bf16(v1[0], v1[1]); w.w = cvt_pk_bf16(v1[2], v1[3]);
                    *(u32x4*)(rowp + bj * HALF) = w; } }
    }
};
template <class Epi, class Sched, bool STAMP = false>
__device__ __forceinline__ void gemm_phase(PG8_LAS unsigned char* lds, const Gemm g, const Sched& S, const Epi& E, unsigned long long* stamps) {
    const int tid = otid(), wid = __builtin_amdgcn_readfirstlane(tid >> 6), lane = tid & 63, wr = wid >> 2, wc = wid & 3, fr = lane & 15, fq = lane >> 4;
    const int K = g.K, nt = K / BK;
    int ts_lo = 0, ts_hi = 0, nts = 0; const unsigned long long rt_entry = STAMP ? (unsigned long long)wall_clock64() : 0ull;
#define PG8_STAMP() do { if (STAMP && wid == 0 && nts < 64) { const unsigned long long _c = (unsigned long long)clock64(); \
        ts_lo = (lane == nts) ? (int)(unsigned)_c : ts_lo; ts_hi = (lane == nts) ? (int)(unsigned)(_c >> 32) : ts_hi; ++nts; } } while (0)
    PG8_STAMP();
    unsigned voffA[2], voffB[2];
#pragma unroll
    for (int i = 0; i < 2; ++i) { int R, C; stage_rc(tid * 16 + i * 8192, R, C); const int Rb = Epi::PERM ? ((R & ~31) + perm32(R & 31)) : R;
        voffA[i] = (unsigned)(R * K + C) * 2u; voffB[i] = (unsigned)(Rb * K + C) * 2u; }
    const size_t kstep = (size_t)(BK * 2);
    const size_t hstep = (size_t)HALF * K * 2;
    const size_t tstep = 2 * hstep;
    const unsigned ldsw = (unsigned)wid * 1024u;
    const int aoff = lds_byte(wr * 64 + fr, fq * 8), boff = lds_byte(wc * 32 + fr, fq * 8);
#define PG8_SA(b, h) (((b) * 2 + (h)) * HTB)
#define PG8_SB(b, h) ((4 + (b) * 2 + (h)) * HTB)
#define PG8_STAGE(bufoff, gbase, voff) do { _Pragma("unroll") for (int _i = 0; _i < 2; ++_i) \
        __builtin_amdgcn_global_load_lds((const unsigned*)((const char*)(gbase) + (voff)[_i]), (PG8_LAS unsigned*)(lds + (bufoff) + ldsw + _i * 8192), 16, 0, 0); } while (0)
#define PG8_LDA(dst, b, h) do { _Pragma("unroll") for (int m = 0; m < 4; ++m) _Pragma("unroll") for (int k = 0; k < 2; ++k) dst[m][k] = *(const PG8_LAS bf16x8*)(lds + PG8_SA(b, h) + aoff + m * 2048 + k * 1024); } while (0)
#define PG8_LDB(dst, b, h) do { _Pragma("unroll") for (int n = 0; n < 2; ++n) _Pragma("unroll") for (int k = 0; k < 2; ++k) dst[n][k] = *(const PG8_LAS bf16x8*)(lds + PG8_SB(b, h) + boff + n * 2048 + k * 1024); } while (0)
#define PG8_MMA(ai, bj, At, Bt) do { __builtin_amdgcn_s_setprio(1); _Pragma("unroll") for (int m = 0; m < 4; ++m) _Pragma("unroll") for (int n = 0; n < 2; ++n) _Pragma("unroll") for (int k = 0; k < 2; ++k) \
        acc[ai][bj][m][n] = __builtin_amdgcn_mfma_f32_16x16x32_bf16(Bt[n][k], At[m][k], acc[ai][bj][m][n], 0, 0, 0); __builtin_amdgcn_s_setprio(0); } while (0)
#define PG8_WAIT_V(n) asm volatile("s_waitcnt vmcnt(" #n ")" ::: "memory")
#define PG8_WAIT_L(n) asm volatile("s_waitcnt lgkmcnt(" #n ")" ::: "memory")
#define PG8_BAR __builtin_amdgcn_s_barrier()
#define PG8_SCHED __builtin_amdgcn_sched_barrier(0)
    Unit cur, nxt; int ui = 0;
    if (!S.next(0, cur)) return;
    f32x4 acc[2][2][4][2];
#pragma unroll
    for (int a = 0; a < 2; ++a)
#pragma unroll
        for (int b = 0; b < 2; ++b)
#pragma unroll
            for (int m = 0; m < 4; ++m)
#pragma unroll
                for (int n = 0; n < 2; ++n) acc[a][b][m][n] = (f32x4){0.f, 0.f, 0.f, 0.f};
    bf16x8 At[4][2], B0[2][2], B1[2][2];
    const char* cA = (const char*)g.A + (size_t)cur.pm * tstep; const char* cB = (const char*)g.Bt + (size_t)cur.pn * tstep;
    S.a_ready(cur);
    PG8_STAGE(PG8_SB(0, 0), cB, voffB); PG8_STAGE(PG8_SA(0, 0), cA, voffA); PG8_STAGE(PG8_SB(0, 1), cB + hstep, voffB); PG8_STAGE(PG8_SA(0, 1), cA + hstep, voffA);
    if (wr == 1) PG8_BAR;
    PG8_WAIT_V(4); PG8_BAR;
    PG8_STAGE(PG8_SB(1, 0), cB + kstep, voffB); PG8_STAGE(PG8_SA(1, 0), cA + kstep, voffA); PG8_STAGE(PG8_SB(1, 1), cB + hstep + kstep, voffB);
    PG8_WAIT_V(6); PG8_BAR;
    PG8_STAMP();
    for (;;) {
        const bool has_next = S.next(ui + 1, nxt);
        const char* nA = has_next ? (const char*)g.A + (size_t)nxt.pm * tstep : cA; const char* nB = has_next ? (const char*)g.Bt + (size_t)nxt.pn * tstep : cB;
        for (int t = 0; t < nt; t += 2) {
            const bool last = (t == nt - 2);
            const char* a1 = cA + (size_t)(t + 1) * kstep;
            const char* a2 = last ? nA : cA + (size_t)(t + 2) * kstep; const char* b2 = last ? nB : cB + (size_t)(t + 2) * kstep;
            const char* a3 = a2 + kstep; const char* b3 = b2 + kstep;
            if (last && has_next) S.a_ready(nxt);
            PG8_LDB(B0, 0, 0); PG8_SCHED; PG8_LDA(At, 0, 0); PG8_STAGE(PG8_SA(1, 1), a1 + hstep, voffA);
            PG8_WAIT_L(8); PG8_BAR; PG8_WAIT_L(0); PG8_MMA(0, 0, At, B0); PG8_BAR; PG8_SCHED;
            PG8_LDB(B1, 0, 1); PG8_STAGE(PG8_SB(0, 0), b2, voffB);
            PG8_BAR; PG8_WAIT_L(0); PG8_MMA(0, 1, At, B1); PG8_BAR;
            PG8_LDA(At, 0, 1); PG8_STAGE(PG8_SA(0, 0), a2, voffA);
            PG8_BAR; PG8_WAIT_L(0); PG8_MMA(1, 0, At, B0); PG8_BAR; PG8_SCHED;
            PG8_STAGE(PG8_SB(0, 1), b2 + hstep, voffB);
            PG8_WAIT_V(6); PG8_BAR; PG8_MMA(1, 1, At, B1); PG8_BAR;
            PG8_LDB(B0, 1, 0); PG8_SCHED; PG8_LDA(At, 1, 0); PG8_STAGE(PG8_SA(0, 1), a2 + hstep, voffA);
            PG8_WAIT_L(8); PG8_BAR; PG8_WAIT_L(0); PG8_MMA(0, 0, At, B0); PG8_BAR; PG8_SCHED;
            PG8_LDB(B1, 1, 1); PG8_STAGE(PG8_SB(1, 0), b3, voffB);
            PG8_BAR; PG8_WAIT_L(0); PG8_MMA(0, 1, At, B1); PG8_BAR;
            PG8_LDA(At, 1, 1); PG8_STAGE(PG8_SA(1, 0), a3, voffA);
            PG8_BAR; PG8_WAIT_L(0); PG8_MMA(1, 0, At, B0); PG8_BAR; PG8_SCHED;
            PG8_STAGE(PG8_SB(1, 1), b3 + hstep, voffB);
            PG8_WAIT_V(6); PG8_BAR; PG8_MMA(1, 1, At, B1); PG8_BAR;
        }
        PG8_STAMP();
        if constexpr (!Epi::AFTER_DRAIN) { E(acc, cur, wr, wc, fr, fq); S.done(cur); }
        PG8_STAMP();
        if (!has_next) break;
#pragma unroll
        for (int a = 0; a < 2; ++a)
#pragma unroll
            for (int b = 0; b < 2; ++b)
#pragma unroll
                for (int m = 0; m < 4; ++m)
#pragma unroll
                    for (int n = 0; n < 2; ++n) acc[a][b][m][n] = (f32x4){0.f, 0.f, 0.f, 0.f};
        cur = nxt; cA = nA; cB = nB; ++ui;
    }
    PG8_WAIT_V(0);
    if (wr == 0) PG8_BAR;
    PG8_BAR;
    if constexpr (Epi::AFTER_DRAIN) { E.fused(acc, cur, wr, wc, fr, fq, lds, wid, lane); S.done(cur); }
    PG8_STAMP();
    if (STAMP && wid == 0) { stamps[lane] = lane < nts ? (((unsigned long long)(unsigned)ts_hi << 32) | (unsigned)ts_lo) : 0ull;
        if (lane == 62) stamps[62] = rt_entry; if (lane == 63) stamps[63] = (unsigned long long)wall_clock64(); }
#undef PG8_STAMP
#undef PG8_SA
#undef PG8_SB
#undef PG8_STAGE
#undef PG8_LDA
#undef PG8_LDB
#undef PG8_MMA
#undef PG8_WAIT_V
#undef PG8_WAIT_L
#undef PG8_BAR
#undef PG8_SCHED
}
}

namespace mk {
using pg8::bf16_t; using pg8::bf16x8; using pg8::f32x4; using pg8::u32x4; using pg8::cvt_pk_bf16;
typedef unsigned u32x2 __attribute__((ext_vector_type(2)));
constexpr int T = 24576, TP = 16384, SS = 2048, DM = 4096, NIN = 9216, DFF = 11008, NGU = 2 * DFF;
constexpr float ALPHA = 1.4142135623730951f;
constexpr float SC2 = 0.08838834764831845f * 1.4426950408889634f;
constexpr size_t OFF_BAR = 0, OFF_WIN = 16384, SZ_WIN = (size_t)2 * NIN * DM * 2, OFF_WOUT = OFF_WIN + SZ_WIN, SZ_WOUT = (size_t)2 * DM * DM * 2,
    OFF_WGU = OFF_WOUT + SZ_WOUT, SZ_WGU = (size_t)2 * NGU * DM * 2, OFF_WD = OFF_WGU + SZ_WGU, SZ_WD = (size_t)2 * DM * DFF * 2,
    OFF_XB = OFF_WD + SZ_WD, SZ_XB = (size_t)T * DM * 2, OFF_VT = OFF_XB + SZ_XB, SZ_VT = (size_t)20 * 128 * T * 2,
    OFF_PROJ = OFF_VT + SZ_VT, SZ_PROJ = (size_t)T * NIN * 2, OFF_MIX = OFF_PROJ + SZ_PROJ, SZ_MIX = (size_t)T * DM * 2, OFF_HDN = OFF_PROJ,
    WS_NEED = OFF_MIX + SZ_MIX;
static_assert((size_t)T * DFF * 2 <= SZ_PROJ + SZ_MIX, "hdn alias");

struct Params { const float* in[15]; float* out; unsigned char* ws; };

__device__ __forceinline__ float bf_lo(unsigned w) { return __uint_as_float(w << 16); }
__device__ __forceinline__ float bf_hi(unsigned w) { return __uint_as_float(w & 0xffff0000u); }

struct EpiResid {
    static constexpr bool PERM = false, AFTER_DRAIN = false;
    float* C; int ldc;
    __device__ __forceinline__ void operator()(const f32x4 (&acc)[2][2][4][2], const pg8::Unit& u, int wr, int wc, int fr, int fq) const {
        const int row0 = u.pm * 256 + wr * 64 + fr, col0 = u.pn * 256 + wc * 32 + 4 * fq;
#pragma unroll
        for (int ai = 0; ai < 2; ++ai)
#pragma unroll
            for (int m = 0; m < 4; ++m) { float* rowp = C + (size_t)(row0 + ai * 128 + m * 16) * ldc + col0;
#pragma unroll
                for (int bj = 0; bj < 2; ++bj)
#pragma unroll
                    for (int n = 0; n < 2; ++n) { f32x4 o = *(const f32x4*)(rowp + bj * 128 + n * 16); o = o * ALPHA + acc[ai][bj][m][n]; *(f32x4*)(rowp + bj * 128 + n * 16) = o; } }
    }
};
struct EpiSwiglu {
    static constexpr bool PERM = true, AFTER_DRAIN = false;
    bf16_t* O; int ldc;
    __device__ __forceinline__ void operator()(const f32x4 (&acc)[2][2][4][2], const pg8::Unit& u, int wr, int wc, int fr, int fq) const {
        const int row0 = u.pm * 256 + wr * 64 + fr, col0 = u.pn * 128 + wc * 32 + 8 * fq;
#pragma unroll
        for (int ai = 0; ai < 2; ++ai)
#pragma unroll
            for (int m = 0; m < 4; ++m) { bf16_t* rowp = O + (size_t)(row0 + ai * 128 + m * 16) * ldc + col0;
                float h[8];
#pragma unroll
                for (int n = 0; n < 2; ++n)
#pragma unroll
                    for (int e = 0; e < 4; ++e) { const float g = acc[ai][0][m][n][e], up = acc[ai][1][m][n][e]; h[n * 4 + e] = g * up * __builtin_amdgcn_rcpf(1.0f + __expf(-g)); }
                u32x4 w; w.x = cvt_pk_bf16(h[0], h[1]); w.y = cvt_pk_bf16(h[2], h[3]); w.z = cvt_pk_bf16(h[4], h[5]); w.w = cvt_pk_bf16(h[6], h[7]);
                *(u32x4*)rowp = w; }
    }
};

__device__ __forceinline__ void wt_phase(LAS unsigned char* lds, const Params& p) {
    LAS float* tile = (LAS float*)lds;
    const int tid = pg8::otid();
    for (int mi = 0; mi < 10; ++mi) {
        const int l = mi / 5, kind = mi % 5;
        const float* src; bf16_t* dst; int K, N, mode = 0;
        if (kind == 0)      { K = DM;  N = NIN; src = p.in[2]  + (size_t)l * K * N; dst = (bf16_t*)(p.ws + OFF_WIN)  + (size_t)l * NIN * DM; }
        else if (kind == 1) { K = DM;  N = DM;  src = p.in[7]  + (size_t)l * K * N; dst = (bf16_t*)(p.ws + OFF_WOUT) + (size_t)l * DM * DM; }
        else if (kind == 2) { K = DM;  N = DFF; src = p.in[10] + (size_t)l * K * N; dst = (bf16_t*)(p.ws + OFF_WGU)  + (size_t)l * NGU * DM; mode = 1; }
        else if (kind == 3) { K = DM;  N = DFF; src = p.in[11] + (size_t)l * K * N; dst = (bf16_t*)(p.ws + OFF_WGU)  + (size_t)l * NGU * DM; mode = 2; }
        else                { K = DFF; N = DM;  src = p.in[12] + (size_t)l * K * N; dst = (bf16_t*)(p.ws + OFF_WD)   + (size_t)l * DM * DFF; }
        const int nkt = K / 64, nst = nkt * (N / 256), G = (int)gridDim.x;
        int t = pg8::obid(); bool have = t < nst;
        f32x4 v[8];
        if (have) { const int k0 = (t % nkt) * 64, n0 = (t / nkt) * 256;
#pragma unroll
            for (int h = 0; h < 8; ++h) { const int idx = tid + 512 * h; v[h] = *(const f32x4*)(src + (size_t)(k0 + (idx >> 6)) * N + n0 + (idx & 63) * 4); } }
        while (have) {
            const int k0 = (t % nkt) * 64, n0 = (t / nkt) * 256;
#pragma unroll
            for (int h = 0; h < 8; ++h) { const int idx = tid + 512 * h; LAS float* d = tile + (idx >> 6) * 257 + (idx & 63) * 4; d[0] = v[h][0]; d[1] = v[h][1]; d[2] = v[h][2]; d[3] = v[h][3]; }
            __syncthreads();
            const int tn = t + G; const bool have_n = tn < nst;
            if (have_n) { const int k1 = (tn % nkt) * 64, n1 = (tn / nkt) * 256;
#pragma unroll
                for (int h = 0; h < 8; ++h) { const int idx = tid + 512 * h; v[h] = *(const f32x4*)(src + (size_t)(k1 + (idx >> 6)) * N + n1 + (idx & 63) * 4); } }
#pragma unroll
            for (int h = 0; h < 4; ++h) { const int idx = tid + 512 * h, nl = idx >> 3, k8 = (idx & 7) * 8, n = n0 + nl;
                const int drow = mode == 0 ? n : ((n >> 7) * 256 + (n & 127) + (mode == 2 ? 128 : 0));
                float f[8];
#pragma unroll
                for (int e = 0; e < 8; ++e) f[e] = tile[(k8 + e) * 257 + nl];
                u32x4 w; w.x = cvt_pk_bf16(f[0], f[1]); w.y = cvt_pk_bf16(f[2], f[3]); w.z = cvt_pk_bf16(f[4], f[5]); w.w = cvt_pk_bf16(f[6], f[7]);
                *(u32x4*)(dst + (size_t)drow * K + k0 + k8) = w; }
            __syncthreads();
            t = tn; have = have_n;
        }
    }
}
__device__ __forceinline__ void xin_phase(const Params& p) {
    bf16_t* xb = (bf16_t*)(p.ws + OFF_XB);
    const size_t n4 = (size_t)T * DM / 4, np4 = (size_t)TP * DM / 4;
    for (size_t i = (size_t)pg8::obid() * 512 + pg8::otid(); i < n4; i += (size_t)gridDim.x * 512) {
        const f32x4 v = i < np4 ? ((const f32x4*)p.in[0])[i] : ((const f32x4*)p.in[1])[i - np4];
        ((f32x4*)p.out)[i] = v;
        u32x2 w; w.x = cvt_pk_bf16(v[0], v[1]); w.y = cvt_pk_bf16(v[2], v[3]); ((u32x2*)xb)[i] = w;
    }
}

__device__ __forceinline__ void prep_phase(LAS unsigned char* lds, const Params& p, int layer) {
    bf16_t* proj = (bf16_t*)(p.ws + OFF_PROJ);
    const int tid = pg8::otid(), j = tid & 15; const int bid = pg8::obid();
    const float* gq = p.in[3] + layer * 128; const float* gk = p.in[4] + layer * 128;
    double invA[8], invB[8];
#pragma unroll
    for (int e = 0; e < 8; ++e) { invA[e] = exp2(-(double)(8 * (j & 1) + e) * (18.931568569324174 / 16.0)) * 0.15915494309189535;
                                  invB[e] = exp2(-(double)(8 * (j & 3) + e) * (13.287712379549449 / 32.0)) * 0.15915494309189535; }
    for (int v = (bid * 512 + tid) >> 4; v < T * 36; v += gridDim.x * 32) {
        const int tok = v / 36, hv = v - tok * 36; const bool isB = hv >= 16;
        const int col = isB ? 3072 + (hv - 16) * 128 : hv * 128;
        bf16_t* ptr = proj + (size_t)tok * NIN + col + j * 8;
        const u32x4 raw = *(const u32x4*)ptr;
        float x[8] = {bf_lo(raw.x), bf_hi(raw.x), bf_lo(raw.y), bf_hi(raw.y), bf_lo(raw.z), bf_hi(raw.z), bf_lo(raw.w), bf_hi(raw.w)};
        float ss = 0.f;
#pragma unroll
        for (int e = 0; e < 8; ++e) ss += x[e] * x[e];
        ss += __shfl_xor(ss, 1); ss += __shfl_xor(ss, 2); ss += __shfl_xor(ss, 4); ss += __shfl_xor(ss, 8);
        const float r = rsqrtf(ss * (1.0f / 128.0f) + 1e-6f);
        const float* gp = (hv - 16 < 16) ? gq : gk;
        const int t = tok < TP ? tok : ((tok - TP) & (SS - 1));
        const bool act = isB || j < 4;
        const bool first = isB ? !(j & 4) : !(j & 2);
        const int ib = isB ? 8 * (j & 3) : 8 * (j & 1);
        const int pos = isB ? (j < 8 ? (t >> 6) : (t & 63)) : t;
        const double lf = isB ? (13.287712379549449 / 32.0) : (18.931568569324174 / 16.0);
#pragma unroll
        for (int e = 0; e < 8; ++e) {
            if (isB) x[e] = x[e] * r * gp[j * 8 + e];
        }
        float o[8];
#pragma unroll
        for (int e = 0; e < 8; ++e) {
            const float pa = __shfl_xor(x[e], 2), pb = __shfl_xor(x[e], 4);
            const float pr = isB ? pb : pa;
            double rev = (double)pos * (isB ? invB[e] : invA[e]); rev -= floor(rev);
            const float fr = (float)rev;
            const float cs = __builtin_amdgcn_cosf(fr), sn = __builtin_amdgcn_sinf(fr);
            const float rot = first ? (x[e] * cs - pr * sn) : (x[e] * cs + pr * sn);
            o[e] = act ? rot : x[e];
        }
        u32x4 w; w.x = cvt_pk_bf16(o[0], o[1]); w.y = cvt_pk_bf16(o[2], o[3]); w.z = cvt_pk_bf16(o[4], o[5]); w.w = cvt_pk_bf16(o[6], o[7]);
        *(u32x4*)ptr = w;
    }
    bf16_t* vtg = (bf16_t*)(p.ws + OFF_VT);
    LAS bf16_t* vt = (LAS bf16_t*)lds;
    for (int tl = bid; tl < (T / 64) * 20; tl += gridDim.x) {
        const int tb = tl / 20, hh = tl - tb * 20;
        const int vcol = hh < 8 ? 2048 + hh * 128 : (hh < 12 ? 5632 + (hh - 8) * 128 : 8192 + (hh - 12) * 128);
#pragma unroll
        for (int h = 0; h < 2; ++h) { const int ch = tid + 512 * h, tokl = ch >> 4, part = ch & 15;
            const u32x4 raw = *(const u32x4*)(proj + (size_t)(tb * 64 + tokl) * NIN + vcol + part * 8);
            LAS unsigned* d = (LAS unsigned*)(vt + tokl * 130 + part * 8);
            d[0] = raw.x; d[1] = raw.y; d[2] = raw.z; d[3] = raw.w; }
        __syncthreads();
#pragma unroll
        for (int h = 0; h < 2; ++h) { const int ch = tid + 512 * h, d = ch & 127, tp = ch >> 7;
            unsigned short s[8];
#pragma unroll
            for (int e = 0; e < 8; ++e) s[e] = vt[(tp * 8 + e) * 130 + d];
            u32x4 w; w.x = s[0] | ((unsigned)s[1] << 16); w.y = s[2] | ((unsigned)s[3] << 16); w.z = s[4] | ((unsigned)s[5] << 16); w.w = s[6] | ((unsigned)s[7] << 16);
            *(u32x4*)(vtg + (size_t)(hh * 128 + d) * T + tb * 64 + tp * 8) = w; }
        __syncthreads();
    }
}

__device__ __forceinline__ float rowmax4(float v) {
    const unsigned a = __float_as_uint(v); const auto r = __builtin_amdgcn_permlane16_swap(a, a, false, false);
    const float m = fmaxf(__uint_as_float(r[0]), __uint_as_float(r[1]));
    const unsigned b = __float_as_uint(m); const auto q = __builtin_amdgcn_permlane32_swap(b, b, false, false);
    return fmaxf(__uint_as_float(q[0]), __uint_as_float(q[1])); }
__device__ __forceinline__ float rowsum4(float v) {
    const unsigned a = __float_as_uint(v); const auto r = __builtin_amdgcn_permlane16_swap(a, a, false, false);
    const float m = __uint_as_float(r[0]) + __uint_as_float(r[1]);
    const unsigned b = __float_as_uint(m); const auto q = __builtin_amdgcn_permlane32_swap(b, b, false, false);
    return __uint_as_float(q[0]) + __uint_as_float(q[1]); }
template <int MODE, int QT>
__device__ __forceinline__ void attn_item(LAS unsigned char* lds, const bf16_t* proj, const bf16_t* vtg, bf16_t* mixed, const float* rpb,
                                          int tok0, int bstart, int s, int head) {
    const int tid = pg8::otid(), w = tid >> 6, lane = tid & 63, c = lane & 15, g = lane >> 4;
    const int t0 = tok0 - bstart;
    int qcol, kcol, vhead, mcol, kb_lo, kb_hi, kbase;
    if (MODE == 0) { qcol = head * 128; kcol = 1024 + head * 128; vhead = head; mcol = head * 128; kbase = t0 - 1024;
        kb_lo = t0 >= 1024 ? 0 : (1024 - t0) >> 6; const int hi = (s - kbase) >> 6; kb_hi = hi < 36 ? hi : 36; }
    else if (MODE == 1) { qcol = 3072 + head * 128; kcol = 5120 + (head >> 2) * 128; vhead = 8 + (head >> 2); mcol = 1024 + head * 128; kbase = 0; kb_lo = 0; kb_hi = s >> 6; }
    else { qcol = 6144 + head * 128; kcol = 7168 + head * 128; vhead = 12 + head; mcol = 3072 + head * 128;
        const int rows = s >> 6, i0 = t0 >> 6; int rlo = i0 - 4; rlo = rlo < 0 ? 0 : (rlo > rows - 8 ? rows - 8 : rlo); int r1 = i0 - 3; r1 = r1 < 0 ? 0 : (r1 > rows - 8 ? rows - 8 : r1);
        kbase = rlo * 64; kb_lo = 0; kb_hi = r1 + 8 - rlo; }
    bf16x8 qf[QT][4];
#pragma unroll
    for (int qt = 0; qt < QT; ++qt)
#pragma unroll
        for (int ks = 0; ks < 4; ++ks) qf[qt][ks] = *(const bf16x8*)(proj + (size_t)(tok0 + (w * QT + qt) * 16 + c) * NIN + qcol + ks * 32 + g * 8);
    f32x4 oacc[QT][8]; float mrun[QT], lsum[QT];
#pragma unroll
    for (int qt = 0; qt < QT; ++qt) { mrun[qt] = -1e30f; lsum[qt] = 0.f;
#pragma unroll
        for (int dg = 0; dg < 8; ++dg) oacc[qt][dg] = (f32x4){0.f, 0.f, 0.f, 0.f}; }
    const int kkey = tid >> 4, kpart = tid & 15;
    const int vd = tid >> 3, vpart = tid & 7;
    const bf16_t* kg0 = proj + (long)(bstart + kbase + kkey) * NIN + kcol + kpart * 8;
    const bf16_t* vg0 = vtg + (long)(vhead * 128 + vd) * T + (long)(bstart + kbase + vpart * 8);
    u32x4 rk0, rk1, rv0, rv1;
#define MK_LOADREGS(kbx) do { const long ko_ = (long)(kbx) * 64 * NIN, vo_ = (long)(kbx) * 64; rk0 = *(const u32x4*)(kg0 + ko_); rk1 = *(const u32x4*)(kg0 + ko_ + (long)32 * NIN); \
        rv0 = *(const u32x4*)(vg0 + vo_); rv1 = *(const u32x4*)(vg0 + vo_ + (long)64 * T); } while (0)
#define MK_WRITEREGS(b) do { LAS unsigned char* Kw = lds + (b) * 35840; LAS unsigned char* Vw = Kw + 17408; \
        *(LAS u32x4*)(Kw + (kkey * 136 + kpart * 8) * 2) = rk0; *(LAS u32x4*)(Kw + ((kkey + 32) * 136 + kpart * 8) * 2) = rk1; \
        { const int vpos = (vpart >> 2) * 32 + (vpart & 1) * 16 + ((vpart & 3) >> 1) * 4; \
          LAS unsigned char* v0 = Vw + (vd * 72 + vpos) * 2; LAS unsigned char* v1 = Vw + ((vd + 64) * 72 + vpos) * 2; \
          u32x2 t_; t_.x = rv0.x; t_.y = rv0.y; *(LAS u32x2*)v0 = t_; t_.x = rv0.z; t_.y = rv0.w; *(LAS u32x2*)(v0 + 16) = t_; \
          t_.x = rv1.x; t_.y = rv1.y; *(LAS u32x2*)v1 = t_; t_.x = rv1.z; t_.y = rv1.w; *(LAS u32x2*)(v1 + 16) = t_; } } while (0)
    __syncthreads();
    u32x4 sk0, sk1, sv0, sv1;
    MK_LOADREGS(kb_lo);
    MK_WRITEREGS(0);
    if (kb_lo + 2 < kb_hi) MK_LOADREGS(kb_lo + 2);
    if (kb_lo + 1 < kb_hi) { const long ko_ = (long)(kb_lo + 1) * 64 * NIN, vo_ = (long)(kb_lo + 1) * 64; sk0 = *(const u32x4*)(kg0 + ko_); sk1 = *(const u32x4*)(kg0 + ko_ + (long)32 * NIN);
        sv0 = *(const u32x4*)(vg0 + vo_); sv1 = *(const u32x4*)(vg0 + vo_ + (long)64 * T); }
#define MK_PV(stg) do { const LAS unsigned char* vb = lds + (stg) * 35840 + 17408 + (c * 72 + g * 8) * 2; \
          bf16x8 vf0[8], vf1[8]; \
          _Pragma("unroll") for (int dg = 0; dg < 8; ++dg) vf0[dg] = *(const LAS bf16x8*)(vb + (dg * 16 * 72) * 2); \
          _Pragma("unroll") for (int dg = 0; dg < 8; ++dg) vf1[dg] = *(const LAS bf16x8*)(vb + (dg * 16 * 72 + 32) * 2); \
          _Pragma("unroll") for (int dg = 0; dg < 8; ++dg) _Pragma("unroll") for (int qt = 0; qt < QT; ++qt) oacc[qt][dg] = __builtin_amdgcn_mfma_f32_16x16x32_bf16(vf0[dg], pf[qt][0], oacc[qt][dg], 0, 0, 0); \
          _Pragma("unroll") for (int dg = 0; dg < 8; ++dg) _Pragma("unroll") for (int qt = 0; qt < QT; ++qt) oacc[qt][dg] = __builtin_amdgcn_mfma_f32_16x16x32_bf16(vf1[dg], pf[qt][1], oacc[qt][dg], 0, 0, 0); } while (0)
    const int gp = __builtin_amdgcn_readfirstlane(w) >> 2;
    bf16x8 pf[QT][2];
    int cur = 0, prv = 0;
    auto body = [&](int kb, u32x4& rk0, u32x4& rk1, u32x4& rv0, u32x4& rv1) __attribute__((always_inline)) {
        const int nxt = cur == 2 ? 0 : cur + 1;
        __syncthreads();
        if (kb + 1 < kb_hi) MK_WRITEREGS(nxt);
        if (kb + 3 < kb_hi) MK_LOADREGS(kb + 3);
        const LAS unsigned char* Ks = lds + cur * 35840;
        f32x4 sacc[QT][4];
#pragma unroll
        for (int qt = 0; qt < QT; ++qt)
#pragma unroll
            for (int kg = 0; kg < 4; ++kg) sacc[qt][kg] = (f32x4){0.f, 0.f, 0.f, 0.f};
        { const LAS unsigned char* kb_ = Ks + (c * 136 + g * 8) * 2;
          bf16x8 kf[4][4];
#pragma unroll
          for (int ks = 0; ks < 4; ++ks)
#pragma unroll
              for (int kg = 0; kg < 4; ++kg) kf[ks][kg] = *(const LAS bf16x8*)(kb_ + (kg * 16 * 136 + ks * 32) * 2);
#pragma unroll
          for (int ks = 0; ks < 4; ++ks)
#pragma unroll
              for (int kg = 0; kg < 4; ++kg)
#pragma unroll
                  for (int qt = 0; qt < QT; ++qt) sacc[qt][kg] = __builtin_amdgcn_mfma_f32_16x16x32_bf16(kf[ks][kg], qf[qt][ks], sacc[qt][kg], 0, 0, 0); }
#pragma unroll
        for (int qt = 0; qt < QT; ++qt) {
            const int qi = (w * QT + qt) * 16 + c;
            float pv[4][4];
            if constexpr (MODE == 1) {
                const f32x4 m4 = __builtin_elementwise_max(__builtin_elementwise_max(sacc[qt][0], sacc[qt][1]), __builtin_elementwise_max(sacc[qt][2], sacc[qt][3]));
                float mx = fmaxf(fmaxf(m4[0], m4[1]), fmaxf(m4[2], m4[3])) * SC2;
                mx = rowmax4(mx);
                const float mnew = fmaxf(mrun[qt], mx), alpha = __builtin_amdgcn_exp2f(mrun[qt] - mnew); mrun[qt] = mnew;
                f32x4 ps4 = (f32x4){0.f, 0.f, 0.f, 0.f};
#pragma unroll
                for (int kg = 0; kg < 4; ++kg) { const f32x4 tt = sacc[qt][kg] * SC2 - mnew;
                    f32x4 pe; pe[0] = __builtin_amdgcn_exp2f(tt[0]); pe[1] = __builtin_amdgcn_exp2f(tt[1]); pe[2] = __builtin_amdgcn_exp2f(tt[2]); pe[3] = __builtin_amdgcn_exp2f(tt[3]);
                    ps4 += pe; pv[kg][0] = pe[0]; pv[kg][1] = pe[1]; pv[kg][2] = pe[2]; pv[kg][3] = pe[3]; }
                lsum[qt] = lsum[qt] * alpha + ((ps4[0] + ps4[1]) + (ps4[2] + ps4[3]));
#pragma unroll
                for (int dg = 0; dg < 8; ++dg) oacc[qt][dg] *= alpha;
            } else {
            float x[4][4]; bool ok[4][4]; float mx = -1e30f;
#pragma unroll
            for (int kg = 0; kg < 4; ++kg)
#pragma unroll
                for (int e = 0; e < 4; ++e) { const int jk = kg * 16 + g * 4 + e; float v = sacc[qt][kg][e] * SC2; bool valid = true;
                    if (MODE == 0) { const int dl = 64 * kb + jk - qi - 1024, ad = dl < 0 ? -dl : dl;
                        const int mult = (ad <= 64 ? 1 : 0) + (((dl & 3) == 0 && ad <= 256) ? 1 : 0) + (((dl & 15) == 0 && ad <= 1024) ? 1 : 0);
                        valid = mult > 0; v += mult == 3 ? 1.5849625007211562f : (mult == 2 ? 1.0f : 0.0f); }
                    if (MODE == 2) { const int rows = s >> 6, ri = (t0 >> 6) + (qi >> 6), qc = qi & 63, rk = (kbase >> 6) + kb;
                        int rs = ri - 4; rs = rs < 0 ? 0 : (rs > rows - 8 ? rows - 8 : rs); int cst = qc - 8; cst = cst < 0 ? 0 : (cst > 48 ? 48 : cst);
                        valid = rk >= rs && rk < rs + 8 && jk >= cst && jk < cst + 16;
                        if (valid) v += rpb[head * 465 + (rk - ri + 7) * 31 + (jk - qc + 15)] * 1.4426950408889634f; }
                    x[kg][e] = v; ok[kg][e] = valid; mx = valid ? fmaxf(mx, v) : mx; }
            mx = rowmax4(mx);
            const float mnew = fmaxf(mrun[qt], mx), alpha = __builtin_amdgcn_exp2f(mrun[qt] - mnew); mrun[qt] = mnew; lsum[qt] *= alpha;
#pragma unroll
            for (int dg = 0; dg < 8; ++dg) oacc[qt][dg] *= alpha;
            float ps = 0.f;
#pragma unroll
            for (int kg = 0; kg < 4; ++kg)
#pragma unroll
                for (int e = 0; e < 4; ++e) { const float pe = ok[kg][e] ? __builtin_amdgcn_exp2f(x[kg][e] - mnew) : 0.f; pv[kg][e] = pe; ps += pe; }
            lsum[qt] += ps;
            }
#pragma unroll
            for (int sI = 0; sI < 2; ++sI) { u32x4 pw; pw.x = cvt_pk_bf16(pv[2 * sI][0], pv[2 * sI][1]); pw.y = cvt_pk_bf16(pv[2 * sI][2], pv[2 * sI][3]);
                pw.z = cvt_pk_bf16(pv[2 * sI + 1][0], pv[2 * sI + 1][1]); pw.w = cvt_pk_bf16(pv[2 * sI + 1][2], pv[2 * sI + 1][3]);
                pf[qt][sI] = __builtin_bit_cast(bf16x8, pw); }
        }
        MK_PV(cur);
        prv = cur; cur = nxt;
    };
    for (int kb = kb_lo; kb < kb_hi; kb += 2) { body(kb, sk0, sk1, sv0, sv1); if (kb + 1 < kb_hi) body(kb + 1, rk0, rk1, rv0, rv1); }
#undef MK_PV
#undef MK_LOADREGS
#undef MK_WRITEREGS
#pragma unroll
    for (int qt = 0; qt < QT; ++qt) {
        const float l = rowsum4(lsum[qt]);
        const float inv = 1.0f / l;
        bf16_t* op = mixed + (size_t)(tok0 + (w * QT + qt) * 16 + c) * DM + mcol + g * 4;
#pragma unroll
        for (int dg = 0; dg < 8; ++dg) { const f32x4 o = oacc[qt][dg] * inv; u32x2 ow; ow.x = cvt_pk_bf16(o[0], o[1]); ow.y = cvt_pk_bf16(o[2], o[3]); *(u32x2*)(op + dg * 16) = ow; }
    }
}

__device__ __forceinline__ void attn_phase(LAS unsigned char* lds, const Params& p, int layer) {
    const bf16_t* proj = (const bf16_t*)(p.ws + OFF_PROJ); const bf16_t* vtg = (const bf16_t*)(p.ws + OFF_VT); bf16_t* mixed = (bf16_t*)(p.ws + OFF_MIX);
    const float* rpb = p.in[5] + layer * (8 * 15 * 31);
    for (int it = pg8::obid(); it < 1024; it += gridDim.x) { const int head = it & 15, qb = it >> 4; attn_item<1, 2>(lds, proj, vtg, mixed, rpb, qb * 256, 0, TP, head); }
    for (int it = pg8::obid(); it < 512; it += gridDim.x) { const int head = it & 15, qb = it >> 4; attn_item<1, 2>(lds, proj, vtg, mixed, rpb, TP + qb * 256, TP + (qb >> 3) * SS, SS, head); }
    for (int it = pg8::obid(); it < 1536; it += gridDim.x) { const int head = it & 7, tok0 = (it >> 3) * 128; const bool pr = tok0 < TP; const int bs = pr ? 0 : TP + ((tok0 - TP) / SS) * SS;
        attn_item<0, 1>(lds, proj, vtg, mixed, rpb, tok0, bs, pr ? TP : SS, head); }
    for (int it = pg8::obid(); it < 1536; it += gridDim.x) { const int head = it & 7, tok0 = (it >> 3) * 128; const bool pr = tok0 < TP; const int bs = pr ? 0 : TP + ((tok0 - TP) / SS) * SS;
        attn_item<2, 1>(lds, proj, vtg, mixed, rpb, tok0, bs, pr ? TP : SS, head); }
}

__device__ __forceinline__ void grms_phase(const Params& p, int layer) {
    bf16_t* mixed = (bf16_t*)(p.ws + OFF_MIX); const float* gg = p.in[6] + layer * DM;
    const int tid0 = pg8::otid(), lane = tid0 & 63, wv = tid0 >> 6; const int bid = pg8::obid();
    for (int tok = bid * 8 + wv; tok < T; tok += gridDim.x * 8) {
        bf16_t* row = mixed + (size_t)tok * DM;
        u32x4 raw[8]; float ssq[3] = {0.f, 0.f, 0.f};
#pragma unroll
        for (int k = 0; k < 8; ++k) { raw[k] = *(const u32x4*)(row + (lane + 64 * k) * 8);
            const float a0 = bf_lo(raw[k].x), a1 = bf_hi(raw[k].x), a2 = bf_lo(raw[k].y), a3 = bf_hi(raw[k].y), a4 = bf_lo(raw[k].z), a5 = bf_hi(raw[k].z), a6 = bf_lo(raw[k].w), a7 = bf_hi(raw[k].w);
            const float q = a0 * a0 + a1 * a1 + a2 * a2 + a3 * a3 + a4 * a4 + a5 * a5 + a6 * a6 + a7 * a7;
            ssq[k < 2 ? 0 : (k < 6 ? 1 : 2)] += q; }
        float sc[3];
#pragma unroll
        for (int gI = 0; gI < 3; ++gI) { float v = ssq[gI];
#pragma unroll
            for (int o = 32; o >= 1; o >>= 1) v += __shfl_xor(v, o);
            sc[gI] = rsqrtf(v / (gI == 1 ? 2048.0f : 1024.0f) + 1e-6f); }
#pragma unroll
        for (int k = 0; k < 8; ++k) { const float r = sc[k < 2 ? 0 : (k < 6 ? 1 : 2)]; const int col = (lane + 64 * k) * 8;
            const f32x4 g0 = *(const f32x4*)(gg + col), g1 = *(const f32x4*)(gg + col + 4);
            u32x4 w; w.x = cvt_pk_bf16(bf_lo(raw[k].x) * r * g0[0], bf_hi(raw[k].x) * r * g0[1]); w.y = cvt_pk_bf16(bf_lo(raw[k].y) * r * g0[2], bf_hi(raw[k].y) * r * g0[3]);
            w.z = cvt_pk_bf16(bf_lo(raw[k].z) * r * g1[0], bf_hi(raw[k].z) * r * g1[1]); w.w = cvt_pk_bf16(bf_lo(raw[k].w) * r * g1[2], bf_hi(raw[k].w) * r * g1[3]);
            *(u32x4*)(row + col) = w; }
    }
}
__device__ __forceinline__ void ln_phase(const Params& p, const float* gam, const float* bet) {
    bf16_t* xb = (bf16_t*)(p.ws + OFF_XB);
    const int tid0 = pg8::otid(), lane = tid0 & 63, wv = tid0 >> 6; const int bid = pg8::obid();
    for (int tok = bid * 8 + wv; tok < T; tok += gridDim.x * 8) {
        float* row = p.out + (size_t)tok * DM;
        f32x4 v[16]; float s = 0.f;
#pragma unroll
        for (int k = 0; k < 16; ++k) { v[k] = *(const f32x4*)(row + (lane + 64 * k) * 4); s += (v[k][0] + v[k][1]) + (v[k][2] + v[k][3]); }
#pragma unroll
        for (int o = 32; o >= 1; o >>= 1) s += __shfl_xor(s, o);
        const float mean = s * (1.0f / DM); float q = 0.f;
#pragma unroll
        for (int k = 0; k < 16; ++k) { const f32x4 d = v[k] - mean; q += (d[0] * d[0] + d[1] * d[1]) + (d[2] * d[2] + d[3] * d[3]); }
#pragma unroll
        for (int o = 32; o >= 1; o >>= 1) q += __shfl_xor(q, o);
        const float rstd = rsqrtf(q * (1.0f / DM) + 1e-5f);
#pragma unroll
        for (int k = 0; k < 16; ++k) { const int col = (lane + 64 * k) * 4; const f32x4 gv = *(const f32x4*)(gam + col), bv = *(const f32x4*)(bet + col);
            const f32x4 o = (v[k] - mean) * rstd * gv + bv; *(f32x4*)(row + col) = o;
            u32x2 w; w.x = cvt_pk_bf16(o[0], o[1]); w.y = cvt_pk_bf16(o[2], o[3]); *(u32x2*)(xb + (size_t)tok * DM + col) = w; }
    }
}

__global__ __launch_bounds__(512, 2) void fwd(Params p) {
    extern __shared__ __attribute__((aligned(16))) unsigned char shm[];
    LAS unsigned char* lds = (LAS unsigned char*)shm;
    volatile LAS unsigned* xbw = (volatile LAS unsigned*)(lds + pg8::STAGE_BYTES);
    if (threadIdx.x < 4) xbw[threadIdx.x] = 0u;
    __syncthreads();
    XcdBarrier bar = xcd_barrier_post((unsigned*)(p.ws + OFF_BAR), xbw);
    const int G = (int)gridDim.x;
    wt_phase(lds, p);
    xin_phase(p);
    xcd_barrier(bar);
    bf16_t* xb = (bf16_t*)(p.ws + OFF_XB); bf16_t* proj = (bf16_t*)(p.ws + OFF_PROJ); bf16_t* mixed = (bf16_t*)(p.ws + OFF_MIX); bf16_t* hdn = (bf16_t*)(p.ws + OFF_HDN);
#pragma unroll 1
    for (int l = 0; l < 2; ++l) {
        { pg8::Gemm g{xb, (const bf16_t*)(p.ws + OFF_WIN) + (size_t)l * NIN * DM, T, NIN, DM}; pg8::StaticOrder S; S.init(T, NIN, G, pg8::obid());
          pg8::EpiBf16<0> E{proj, NIN, nullptr, 0, 0}; pg8::gemm_phase<pg8::EpiBf16<0>, pg8::StaticOrder, false>(lds, g, S, E, nullptr); }
        xcd_barrier(bar);
        prep_phase(lds, p, l);
        xcd_barrier(bar);
        attn_phase(lds, p, l);
        xcd_barrier(bar);
        grms_phase(p, l);
        xcd_barrier(bar);
        { pg8::Gemm g{mixed, (const bf16_t*)(p.ws + OFF_WOUT) + (size_t)l * DM * DM, T, DM, DM}; pg8::StaticOrder S; S.init(T, DM, G, pg8::obid());
          EpiResid E{p.out, DM}; pg8::gemm_phase<EpiResid, pg8::StaticOrder, false>(lds, g, S, E, nullptr); }
        xcd_barrier(bar);
        ln_phase(p, p.in[8] + l * DM, p.in[9] + l * DM);
        xcd_barrier(bar);
        { pg8::Gemm g{xb, (const bf16_t*)(p.ws + OFF_WGU) + (size_t)l * NGU * DM, T, NGU, DM}; pg8::StaticOrder S; S.init(T, NGU, G, pg8::obid());
          EpiSwiglu E{hdn, DFF}; pg8::gemm_phase<EpiSwiglu, pg8::StaticOrder, false>(lds, g, S, E, nullptr); }
        xcd_barrier(bar);
        { pg8::Gemm g{hdn, (const bf16_t*)(p.ws + OFF_WD) + (size_t)l * DM * DFF, T, DM, DFF}; pg8::StaticOrder S; S.init(T, DM, G, pg8::obid());
          EpiResid E{p.out, DM}; pg8::gemm_phase<EpiResid, pg8::StaticOrder, false>(lds, g, S, E, nullptr); }
        xcd_barrier(bar);
        ln_phase(p, p.in[13] + l * DM, p.in[14] + l * DM);
        xcd_barrier(bar);
    }
}
}

extern "C" void kernel_launch(void* const* d_in, const int* in_sizes, int n_in, void* d_out, int out_size, void* d_ws, size_t ws_size, hipStream_t stream) {
    constexpr int LDSB = pg8::STAGE_BYTES + 16;
    static int grid = 0;
    if (!grid) {
        int dev = 0, cus = 0, per_cu = 0;
        hipGetDevice(&dev);
        hipDeviceGetAttribute(&cus, hipDeviceAttributeMultiprocessorCount, dev);
        if (hipFuncSetAttribute((const void*)mk::fwd, hipFuncAttributeMaxDynamicSharedMemorySize, LDSB) != hipSuccess) { fprintf(stderr, "hipFuncSetAttribute failed\n"); grid = -1; }
        else if (hipOccupancyMaxActiveBlocksPerMultiprocessor(&per_cu, (const void*)mk::fwd, 512, LDSB) != hipSuccess || per_cu < 1) { fprintf(stderr, "occupancy query failed\n"); grid = -1; }
        else grid = cus;
    }
    if (grid <= 0 || ws_size < mk::WS_NEED || n_in < 15) { fprintf(stderr, "kernel_launch: refused (grid %d, ws %zu need %zu)\n", grid, ws_size, (size_t)mk::WS_NEED); return; }
    hipMemsetAsync((unsigned char*)d_ws + mk::OFF_BAR, 0, 16384, stream);
    mk::Params p{};
    for (int i = 0; i < 15; ++i) p.in[i] = (const float*)d_in[i];
    p.out = (float*)d_out; p.ws = (unsigned char*)d_ws;
    hipLaunchKernelGGL(mk::fwd, dim3(grid), dim3(512), LDSB, stream, p);
}
```

```cpp
#include <hip/hip_runtime.h>
#include <cstdio>
#include <cstdint>
#define XB_TMO      128
#define XB_XCNT(j)  (256  + 64 * (j))
#define XB_XSUB(j)  (1280 + 64 * (j))
#define XB_XGEN(j)  (2304 + 64 * (j))
#define XB_TOP      3328
#define XB_TOPGEN   3392
#define XCD_BAR_WORDS 3456
#define XB_SPIN_CAP (1u << 18)
#define LAS __attribute__((address_space(3)))

__device__ __forceinline__ unsigned xb_ld(unsigned* p)              { return __hip_atomic_load(p, __ATOMIC_RELAXED, __HIP_MEMORY_SCOPE_AGENT); }
__device__ __forceinline__ unsigned xb_add(unsigned* p, unsigned v) { return __hip_atomic_fetch_add(p, v, __ATOMIC_RELAXED, __HIP_MEMORY_SCOPE_AGENT); }
__device__ __forceinline__ unsigned xb_xcc_id() { return (unsigned)__builtin_amdgcn_s_getreg((3 << 11) | 20) & 0xFu; }
#define XB_SPIN(cond, bar) do { unsigned _sp = 0; while (cond) { __builtin_amdgcn_s_sleep(1); \
    if ((++_sp & 255u) == 0u) { if (xb_ld(&(bar)[XB_TMO])) break; if (_sp > XB_SPIN_CAP) { atomicAdd(&(bar)[XB_TMO], 1u); break; } } } } while (0)

struct XcdBarrier {
    unsigned* bar; unsigned x;
    volatile LAS unsigned* st;
};

__device__ __forceinline__ XcdBarrier xcd_barrier_post(unsigned* bar, volatile LAS unsigned* st) {
    XcdBarrier b; b.bar = bar; b.x = xb_xcc_id(); b.st = st;
    if (threadIdx.x == 0) (void)xb_add(&bar[XB_XCNT(b.x)], 1u);
    return b;
}
__device__ __forceinline__ void xcd_barrier_complete(unsigned* bar, unsigned x, unsigned& nloc, unsigned& nx) {
    const unsigned G = gridDim.x * gridDim.y * gridDim.z;
    unsigned sum, cnt, mine, sp = 0u;
    for (;;) {
        sum = 0u; cnt = 0u; mine = 0u;
#pragma unroll
        for (unsigned j = 0; j < 16; ++j) { const unsigned c = xb_ld(&bar[XB_XCNT(j)]); sum += c; cnt += (c > 0u) ? 1u : 0u; mine = (j == x) ? c : mine; }
        if (sum == G) break;
        __builtin_amdgcn_s_sleep(1);
        if ((++sp & 255u) == 0u) { if (xb_ld(&bar[XB_TMO])) break; if (sp > XB_SPIN_CAP) { atomicAdd(&bar[XB_TMO], 1u); break; } }
    }
    nloc = mine > 0u ? mine : 1u; nx = cnt > 0u ? cnt : 1u;
}

__device__ __forceinline__ void xcd_barrier(const XcdBarrier& b) {
    asm volatile("s_waitcnt vmcnt(0)" ::: "memory");
    __syncthreads();
    if (threadIdx.x == 0) {
        unsigned* bar = b.bar; unsigned bx = xb_xcc_id(); asm volatile("" : "+s"(bx));
        __builtin_amdgcn_s_waitcnt(0);
        unsigned nloc = b.st[0], nx = b.st[1];
        if (nloc == 0u) { xcd_barrier_complete(bar, bx, nloc, nx); b.st[0] = nloc; b.st[1] = nx; }
        const unsigned old = xb_add(&bar[XB_XSUB(bx)], 1u);
        const unsigned gen = old / nloc;
        if (old + 1u == (gen + 1u) * nloc) {
            __builtin_amdgcn_fence(__ATOMIC_RELEASE, "agent");
            asm volatile("s_waitcnt vmcnt(0)" ::: "memory");
            const unsigned og = xb_add(&bar[XB_TOP], 1u);
            const unsigned tg = og / nx;
            if (og + 1u == (tg + 1u) * nx) xb_add(&bar[XB_TOPGEN], 1u);
            else XB_SPIN(xb_ld(&bar[XB_TOPGEN]) == tg, bar);
            __builtin_amdgcn_fence(__ATOMIC_ACQUIRE, "agent");
            xb_add(&bar[XB_XGEN(bx)], 1u);
            asm volatile("s_waitcnt vmcnt(0)" ::: "memory");
        } else {
            XB_SPIN(xb_ld(&bar[XB_XGEN(bx)]) == gen, bar);
            __builtin_amdgcn_fence(__ATOMIC_ACQUIRE, "agent");
            asm volatile("s_waitcnt vmcnt(0)" ::: "memory");
        }
    }
    __syncthreads();
}
namespace pg8 {
__device__ __forceinline__ int otid() { int t = (int)threadIdx.x; asm volatile("" : "+v"(t)); return t; }
__device__ __forceinline__ int obid() { int b = (int)blockIdx.x; asm volatile("" : "+s"(b)); return b; }

#define PG8_LAS __attribute__((address_space(3)))
typedef unsigned short bf16_t;
typedef short bf16x8 __attribute__((ext_vector_type(8)));
typedef float f32x4 __attribute__((ext_vector_type(4)));
typedef unsigned u32x4 __attribute__((ext_vector_type(4)));
constexpr int BM = 256, BK = 64, HALF = 128, HTB = HALF * BK * 2  , STAGE_BYTES = 8 * HTB, NXCD = 8, WGM = 8;

__host__ __device__ __forceinline__ int lds_byte(int r, int c) { const int st = (r >> 4) * 2 + (c >> 5), rr = r & 15, cc = c & 31, ob = rr * 64 + cc * 2; return st * 1024 + (ob ^ (((ob >> 9) & 1) << 5)); }
__host__ __device__ __forceinline__ void stage_rc(int b, int& R, int& C) { const int st = b / 1024, sb = b % 1024, swz = sb ^ (((sb >> 9) & 1) << 5); R = (st >> 1) * 16 + swz / 64; C = (st & 1) * 32 + (swz % 64) / 2; }
__host__ __device__ __forceinline__ int perm32(int rho) { const int n = rho >> 4, i = rho & 15; return 8 * (i >> 2) + 4 * n + (i & 3); }

struct Unit { int pm, pn; };
struct Gemm { const bf16_t* A; const bf16_t* Bt; int M, N, K; };

struct StaticOrder {
    int nM, nN, nwg, G, c;
    __host__ __device__ void init(int M, int N, int G_, int c_) { nM = M / BM; nN = N / BM; nwg = nM * nN; G = G_; c = c_; }
    __host__ __device__ bool next(int i, Unit& u) const {
        const long L = (long)i * G + c; if (L >= nwg) return false;
        int wgid = (int)L; { const int q = nwg / NXCD, r = nwg % NXCD, xcd = wgid % NXCD, off = wgid / NXCD; wgid = (xcd < r ? xcd * (q + 1) : r * (q + 1) + (xcd - r) * q) + off; }
        const int nig = WGM * nN, gid = wgid / nig, fm = gid * WGM, gsz = (nM - fm) < WGM ? (nM - fm) : WGM;
        u.pm = fm + ((wgid % nig) % gsz); u.pn = (wgid % nig) / gsz; return true;
    }
    __device__ __forceinline__ void a_ready(const Unit&) const {}
    __device__ __forceinline__ void done(const Unit&) const {}
};
struct CountedOrder : StaticOrder {
    const unsigned* ready; unsigned need; unsigned* tmo;
    __device__ __forceinline__ void a_ready(const Unit& u) const {
        if (threadIdx.x < 64) {
            const unsigned long long t0 = __builtin_amdgcn_s_memrealtime(); unsigned polls = 0;
            while ((unsigned)__builtin_amdgcn_readfirstlane(__hip_atomic_load(ready + 64 * u.pm, __ATOMIC_RELAXED, __HIP_MEMORY_SCOPE_AGENT)) < need) {
                if ((++polls & 255u) == 0u && __builtin_amdgcn_readfirstlane(__hip_atomic_load(tmo, __ATOMIC_RELAXED, __HIP_MEMORY_SCOPE_AGENT)) != 0u) break;
                if (__builtin_amdgcn_s_memrealtime() - t0 > 2000000ull) {
                    if (threadIdx.x == 0) { unsigned expect = 0u; __hip_atomic_compare_exchange_strong(tmo + 1, &expect, 0x600u | (unsigned)(u.pm & 0xff), __ATOMIC_RELAXED, __ATOMIC_RELAXED, __HIP_MEMORY_SCOPE_AGENT); __hip_atomic_store(tmo, 1u, __ATOMIC_RELAXED, __HIP_MEMORY_SCOPE_AGENT); }
                    break; }
                __builtin_amdgcn_s_sleep(2); }
            __builtin_amdgcn_fence(__ATOMIC_ACQUIRE, "agent");
            asm volatile("s_waitcnt vmcnt(0)" ::: "memory");
        }
#if !defined(BROKEN_HOOK_NO_BARRIER)
        asm volatile("" ::: "memory"); __builtin_amdgcn_s_barrier(); asm volatile("" ::: "memory");
#endif
    }
};

__device__ __forceinline__ unsigned cvt_pk_bf16(float lo, float hi) { unsigned r; asm volatile("v_cvt_pk_bf16_f32 %0, %1, %2" : "=v"(r) : "v"(lo), "v"(hi)); return r; }
typedef float f32x2 __attribute__((ext_vector_type(2)));
__device__ __forceinline__ f32x2 gelu_pk(f32x2 v) {
    const f32x2 av = __builtin_elementwise_abs(v), d = av * 0.2316418882f + 1.0f;
    f32x2 t; t.x = __builtin_amdgcn_rcpf(d.x); t.y = __builtin_amdgcn_rcpf(d.y);
    f32x2 q = t * 0.5307027145f + (-0.7265760135f); q = q * t + 0.7107068705f; q = q * t + (-0.142248368f); q = q * t + 0.127414796f; q = q * t;
    const f32x2 s = (v * v) * (-0.72134752044f);
    f32x2 e; e.x = __builtin_amdgcn_exp2f(s.x); e.y = __builtin_amdgcn_exp2f(s.y);
    const f32x2 m = v * (q * e), r = v - m;
    f32x2 o; o.x = v.x < 0.f ? m.x : r.x; o.y = v.y < 0.f ? m.y : r.y; return o;
}

struct EpiF32 {
    static constexpr bool PERM = false, AFTER_DRAIN = false;
    float* C; int ldc; const float* bias;
    __device__ __forceinline__ void operator()(const f32x4 (&acc)[2][2][4][2], const Unit& u, int wr, int wc, int fr, int fq) const {
        const int row0 = u.pm * BM + wr * 64 + fr, col0 = u.pn * BM + wc * 32 + 4 * fq;
        f32x4 bv[2][2];
#pragma unroll
        for (int bj = 0; bj < 2; ++bj)
#pragma unroll
            for (int n = 0; n < 2; ++n) bv[bj][n] = bias ? *(const f32x4*)(bias + col0 + bj * HALF + n * 16) : (f32x4){0.f, 0.f, 0.f, 0.f};
#pragma unroll
        for (int ai = 0; ai < 2; ++ai)
#pragma unroll
            for (int m = 0; m < 4; ++m) { float* rowp = C + (size_t)(row0 + ai * HALF + m * 16) * ldc + col0;
#pragma unroll
                for (int bj = 0; bj < 2; ++bj)
#pragma unroll
                    for (int n = 0; n < 2; ++n) *(f32x4*)(rowp + bj * HALF + n * 16) = acc[ai][bj][m][n] + bv[bj][n]; }
    }
};
template <int ACT  > struct EpiBf16 {
    static constexpr bool PERM = true, AFTER_DRAIN = false;
    bf16_t* O; int ldc; const float* bias; int split_cols; size_t split_stride;
    __device__ __forceinline__ void operator()(const f32x4 (&acc)[2][2][4][2], const Unit& u, int wr, int wc, int fr, int fq) const {
        const int row0 = u.pm * BM + wr * 64 + fr; int colt = u.pn * BM; bf16_t* base = O;
        if (split_cols) { const int t = colt / split_cols; base += (size_t)t * split_stride; colt -= t * split_cols; }
        const int col0 = colt + wc * 32 + 8 * fq, bcol0 = u.pn * BM + wc * 32 + 8 * fq;
        f32x4 bv[2][2];
#pragma unroll
        for (int bj = 0; bj < 2; ++bj)
#pragma unroll
            for (int n = 0; n < 2; ++n) bv[bj][n] = bias ? *(const f32x4*)(bias + bcol0 + bj * HALF + 4 * n) : (f32x4){0.f, 0.f, 0.f, 0.f};
#pragma unroll
        for (int ai = 0; ai < 2; ++ai)
#pragma unroll
            for (int m = 0; m < 4; ++m) { bf16_t* rowp = base + (size_t)(row0 + ai * HALF + m * 16) * ldc + col0;
#pragma unroll
                for (int bj = 0; bj < 2; ++bj) { f32x4 v0 = acc[ai][bj][m][0] + bv[bj][0], v1 = acc[ai][bj][m][1] + bv[bj][1];
                    if (ACT == 1) { f32x2 a = gelu_pk((f32x2){v0[0], v0[1]}), b = gelu_pk((f32x2){v0[2], v0[3]}), c = gelu_pk((f32x2){v1[0], v1[1]}), d = gelu_pk((f32x2){v1[2], v1[3]});
                        v0 = (f32x4){a.x, a.y, b.x, b.y}; v1 = (f32x4){c.x, c.y, d.x, d.y}; }
                    if (ACT == 2) {
#pragma unroll
                        for (int j = 0; j < 4; ++j) { v0[j] = 0.5f * v0[j] * (1.0f + erff(v0[j] * 0.70710678f)); v1[j] = 0.5f * v1[j] * (1.0f + erff(v1[j] * 0.70710678f)); } }
                    u32x4 w; w.x = cvt_pk_bf16(v0[0], v0[1]); w.y = cvt_pk_bf16(v0[2], v0[3]); w.z = cvt_pk_bf16(v1[0], v1[1]); w.w = cvt_pk_bf16(v1[2], v1[3]);
                    *(u32x4*)(rowp + bj * HALF) = w; } }
    }
};
template <class Epi, class Sched, bool STAMP = false>
__device__ __forceinline__ void gemm_phase(PG8_LAS unsigned char* lds, const Gemm g, const Sched& S, const Epi& E, unsigned long long* stamps) {
    const int tid = otid(), wid = __builtin_amdgcn_readfirstlane(tid >> 6), lane = tid & 63, wr = wid >> 2, wc = wid & 3, fr = lane & 15, fq = lane >> 4;
    const int K = g.K, nt = K / BK;
    int ts_lo = 0, ts_hi = 0, nts = 0; const unsigned long long rt_entry = STAMP ? (unsigned long long)wall_clock64() : 0ull;
#define PG8_STAMP() do { if (STAMP && wid == 0 && nts < 64) { const unsigned long long _c = (unsigned long long)clock64(); \
        ts_lo = (lane == nts) ? (int)(unsigned)_c : ts_lo; ts_hi = (lane == nts) ? (int)(unsigned)(_c >> 32) : ts_hi; ++nts; } } while (0)
    PG8_STAMP();
    unsigned voffA[2], voffB[2];
#pragma unroll
    for (int i = 0; i < 2; ++i) { int R, C; stage_rc(tid * 16 + i * 8192, R, C); const int Rb = Epi::PERM ? ((R & ~31) + perm32(R & 31)) : R;
        voffA[i] = (unsigned)(R * K + C) * 2u; voffB[i] = (unsigned)(Rb * K + C) * 2u; }
    const size_t kstep = (size_t)(BK * 2);
    const size_t hstep = (size_t)HALF * K * 2;
    const size_t tstep = 2 * hstep;
    const unsigned ldsw = (unsigned)wid * 1024u;
    const int aoff = lds_byte(wr * 64 + fr, fq * 8), boff = lds_byte(wc * 32 + fr, fq * 8);
#define PG8_SA(b, h) (((b) * 2 + (h)) * HTB)
#define PG8_SB(b, h) ((4 + (b) * 2 + (h)) * HTB)
#define PG8_STAGE(bufoff, gbase, voff) do { _Pragma("unroll") for (int _i = 0; _i < 2; ++_i) \
        __builtin_amdgcn_global_load_lds((const unsigned*)((const char*)(gbase) + (voff)[_i]), (PG8_LAS unsigned*)(lds + (bufoff) + ldsw + _i * 8192), 16, 0, 0); } while (0)
#define PG8_LDA(dst, b, h) do { _Pragma("unroll") for (int m = 0; m < 4; ++m) _Pragma("unroll") for (int k = 0; k < 2; ++k) dst[m][k] = *(const PG8_LAS bf16x8*)(lds + PG8_SA(b, h) + aoff + m * 2048 + k * 1024); } while (0)
#define PG8_LDB(dst, b, h) do { _Pragma("unroll") for (int n = 0; n < 2; ++n) _Pragma("unroll") for (int k = 0; k < 2; ++k) dst[n][k] = *(const PG8_LAS bf16x8*)(lds + PG8_SB(b, h) + boff + n * 2048 + k * 1024); } while (0)
#define PG8_MMA(ai, bj, At, Bt) do { __builtin_amdgcn_s_setprio(1); _Pragma("unroll") for (int m = 0; m < 4; ++m) _Pragma("unroll") for (int n = 0; n < 2; ++n) _Pragma("unroll") for (int k = 0; k < 2; ++k) \
        acc[ai][bj][m][n] = __builtin_amdgcn_mfma_f32_16x16x32_bf16(Bt[n][k], At[m][k], acc[ai][bj][m][n], 0, 0, 0); __builtin_amdgcn_s_setprio(0); } while (0)
#define PG8_WAIT_V(n) asm volatile("s_waitcnt vmcnt(" #n ")" ::: "memory")
#define PG8_WAIT_L(n) asm volatile("s_waitcnt lgkmcnt(" #n ")" ::: "memory")
#define PG8_BAR __builtin_amdgcn_s_barrier()
#define PG8_SCHED __builtin_amdgcn_sched_barrier(0)
    Unit cur, nxt; int ui = 0;
    if (!S.next(0, cur)) return;
    f32x4 acc[2][2][4][2];
#pragma unroll
    for (int a = 0; a < 2; ++a)
#pragma unroll
        for (int b = 0; b < 2; ++b)
#pragma unroll
            for (int m = 0; m < 4; ++m)
#pragma unroll
                for (int n = 0; n < 2; ++n) acc[a][b][m][n] = (f32x4){0.f, 0.f, 0.f, 0.f};
    bf16x8 At[4][2], B0[2][2], B1[2][2];
    const char* cA = (const char*)g.A + (size_t)cur.pm * tstep; const char* cB = (const char*)g.Bt + (size_t)cur.pn * tstep;
    S.a_ready(cur);
    PG8_STAGE(PG8_SB(0, 0), cB, voffB); PG8_STAGE(PG8_SA(0, 0), cA, voffA); PG8_STAGE(PG8_SB(0, 1), cB + hstep, voffB); PG8_STAGE(PG8_SA(0, 1), cA + hstep, voffA);
    if (wr == 1) PG8_BAR;
    PG8_WAIT_V(4); PG8_BAR;
    PG8_STAGE(PG8_SB(1, 0), cB + kstep, voffB); PG8_STAGE(PG8_SA(1, 0), cA + kstep, voffA); PG8_STAGE(PG8_SB(1, 1), cB + hstep + kstep, voffB);
    PG8_WAIT_V(6); PG8_BAR;
    PG8_STAMP();
    for (;;) {
        const bool has_next = S.next(ui + 1, nxt);
        const char* nA = has_next ? (const char*)g.A + (size_t)nxt.pm * tstep : cA; const char* nB = has_next ? (const char*)g.Bt + (size_t)nxt.pn * tstep : cB;
        for (int t = 0; t < nt; t += 2) {
            const bool last = (t == nt - 2);
            const char* a1 = cA + (size_t)(t + 1) * kstep;
            const char* a2 = last ? nA : cA + (size_t)(t + 2) * kstep; const char* b2 = last ? nB : cB + (size_t)(t + 2) * kstep;
            const char* a3 = a2 + kstep; const char* b3 = b2 + kstep;
            if (last && has_next) S.a_ready(nxt);
            PG8_LDB(B0, 0, 0); PG8_SCHED; PG8_LDA(At, 0, 0); PG8_STAGE(PG8_SA(1, 1), a1 + hstep, voffA);
            PG8_WAIT_L(8); PG8_BAR; PG8_WAIT_L(0); PG8_MMA(0, 0, At, B0); PG8_BAR; PG8_SCHED;
            PG8_LDB(B1, 0, 1); PG8_STAGE(PG8_SB(0, 0), b2, voffB);
            PG8_BAR; PG8_WAIT_L(0); PG8_MMA(0, 1, At, B1); PG8_BAR;
            PG8_LDA(At, 0, 1); PG8_STAGE(PG8_SA(0, 0), a2, voffA);
            PG8_BAR; PG8_WAIT_L(0); PG8_MMA(1, 0, At, B0); PG8_BAR; PG8_SCHED;
            PG8_STAGE(PG8_SB(0, 1), b2 + hstep, voffB);
            PG8_WAIT_V(6); PG8_BAR; PG8_MMA(1, 1, At, B1); PG8_BAR;
            PG8_LDB(B0, 1, 0); PG8_SCHED; PG8_LDA(At, 1, 0); PG8_STAGE(PG8_SA(0, 1), a2 + hstep, voffA);
            PG8_WAIT_L(8); PG8_BAR; PG8_WAIT_L(0); PG8_MMA(0, 0, At, B0); PG8_BAR; PG8_SCHED;
            PG8_LDB(B1, 1, 1); PG8_STAGE(PG8_SB(1, 0), b3, voffB);
            PG8_BAR; PG8_WAIT_L(0); PG8_MMA(0, 1, At, B1); PG8_BAR;
            PG8_LDA(At, 1, 1); PG8_STAGE(PG8_SA(1, 0), a3, voffA);
            PG8_BAR; PG8_WAIT_L(0); PG8_MMA(1, 0, At, B0); PG8_BAR; PG8_SCHED;
            PG8_STAGE(PG8_SB(1, 1), b3 + hstep, voffB);
            PG8_WAIT_V(6); PG8_BAR; PG8_MMA(1, 1, At, B1); PG8_BAR;
        }
        PG8_STAMP();
        if constexpr (!Epi::AFTER_DRAIN) { E(acc, cur, wr, wc, fr, fq); S.done(cur); }
        PG8_STAMP();
        if (!has_next) break;
#pragma unroll
        for (int a = 0; a < 2; ++a)
#pragma unroll
            for (int b = 0; b < 2; ++b)
#pragma unroll
                for (int m = 0; m < 4; ++m)
#pragma unroll
                    for (int n = 0; n < 2; ++n) acc[a][b][m][n] = (f32x4){0.f, 0.f, 0.f, 0.f};
        cur = nxt; cA = nA; cB = nB; ++ui;
    }
    PG8_WAIT_V(0);
    if (wr == 0) PG8_BAR;
    PG8_BAR;
    if constexpr (Epi::AFTER_DRAIN) { E.fused(acc, cur, wr, wc, fr, fq, lds, wid, lane); S.done(cur); }
    PG8_STAMP();
    if (STAMP && wid == 0) { stamps[lane] = lane < nts ? (((unsigned long long)(unsigned)ts_hi << 32) | (unsigned)ts_lo) : 0ull;
        if (lane == 62) stamps[62] = rt_entry; if (lane == 63) stamps[63] = (unsigned long long)wall_clock64(); }
#undef PG8_STAMP
#undef PG8_SA
#undef PG8_SB
#undef PG8_STAGE
#undef PG8_LDA
#undef PG8_LDB
#undef PG8_MMA
#undef PG8_WAIT_V
#undef PG8_WAIT_L
#undef PG8_BAR
#undef PG8_SCHED
}
}

namespace mk {
using pg8::bf16_t; using pg8::bf16x8; using pg8::f32x4; using pg8::u32x4; using pg8::cvt_pk_bf16;
typedef unsigned u32x2 __attribute__((ext_vector_type(2)));
constexpr int T = 24576, TP = 16384, SS = 2048, DM = 4096, NIN = 9216, DFF = 11008, NGU = 2 * DFF;
constexpr float ALPHA = 1.4142135623730951f;
constexpr float SC2 = 0.08838834764831845f * 1.4426950408889634f;
constexpr size_t OFF_BAR = 0, OFF_WIN = 16384, SZ_WIN = (size_t)2 * NIN * DM * 2, OFF_WOUT = OFF_WIN + SZ_WIN, SZ_WOUT = (size_t)2 * DM * DM * 2,
    OFF_WGU = OFF_WOUT + SZ_WOUT, SZ_WGU = (size_t)2 * NGU * DM * 2, OFF_WD = OFF_WGU + SZ_WGU, SZ_WD = (size_t)2 * DM * DFF * 2,
    OFF_XB = OFF_WD + SZ_WD, SZ_XB = (size_t)T * DM * 2, OFF_VT = OFF_XB + SZ_XB, SZ_VT = (size_t)20 * 128 * T * 2,
    OFF_PROJ = OFF_VT + SZ_VT, SZ_PROJ = (size_t)T * NIN * 2, OFF_MIX = OFF_PROJ + SZ_PROJ, SZ_MIX = (size_t)T * DM * 2, OFF_HDN = OFF_PROJ,
    WS_NEED = OFF_MIX + SZ_MIX;
static_assert((size_t)T * DFF * 2 <= SZ_PROJ + SZ_MIX, "hdn alias");

struct Params { const float* in[15]; float* out; unsigned char* ws; };

__device__ __forceinline__ float bf_lo(unsigned w) { return __uint_as_float(w << 16); }
__device__ __forceinline__ float bf_hi(unsigned w) { return __uint_as_float(w & 0xffff0000u); }

struct EpiResid {
    static constexpr bool PERM = false, AFTER_DRAIN = false;
    float* C; int ldc; const float* src0; const float* src1;
    __device__ __forceinline__ void operator()(const f32x4 (&acc)[2][2][4][2], const pg8::Unit& u, int wr, int wc, int fr, int fq) const {
        const int row0 = u.pm * 256 + wr * 64 + fr, col0 = u.pn * 256 + wc * 32 + 4 * fq;
        const float* S = (u.pm * 256 < TP) ? src0 : src1;
#pragma unroll
        for (int ai = 0; ai < 2; ++ai)
#pragma unroll
            for (int m = 0; m < 4; ++m) { const size_t ro = (size_t)(row0 + ai * 128 + m * 16) * ldc + col0; float* rowp = C + ro; const float* srcp = S + ro;
#pragma unroll
                for (int bj = 0; bj < 2; ++bj)
#pragma unroll
                    for (int n = 0; n < 2; ++n) { f32x4 o = *(const f32x4*)(srcp + bj * 128 + n * 16); o = o * ALPHA + acc[ai][bj][m][n]; *(f32x4*)(rowp + bj * 128 + n * 16) = o; } }
    }
};
struct EpiSwiglu {
    static constexpr bool PERM = true, AFTER_DRAIN = false;
    bf16_t* O; int ldc;
    __device__ __forceinline__ void operator()(const f32x4 (&acc)[2][2][4][2], const pg8::Unit& u, int wr, int wc, int fr, int fq) const {
        const int row0 = u.pm * 256 + wr * 64 + fr, col0 = u.pn * 128 + wc * 32 + 8 * fq;
#pragma unroll
        for (int ai = 0; ai < 2; ++ai)
#pragma unroll
            for (int m = 0; m < 4; ++m) { bf16_t* rowp = O + (size_t)(row0 + ai * 128 + m * 16) * ldc + col0;
                float h[8];
#pragma unroll
                for (int n = 0; n < 2; ++n)
#pragma unroll
                    for (int e = 0; e < 4; ++e) { const float g = acc[ai][0][m][n][e], up = acc[ai][1][m][n][e]; h[n * 4 + e] = g * up * __builtin_amdgcn_rcpf(1.0f + __expf(-g)); }
                u32x4 w; w.x = cvt_pk_bf16(h[0], h[1]); w.y = cvt_pk_bf16(h[2], h[3]); w.z = cvt_pk_bf16(h[4], h[5]); w.w = cvt_pk_bf16(h[6], h[7]);
                *(u32x4*)rowp = w; }
    }
};

__device__ __forceinline__ void wt_phase(LAS unsigned char* lds, const Params& p) {
    LAS float* tile = (LAS float*)lds;
    const int tid = pg8::otid();
    for (int mi = 0; mi < 10; ++mi) {
        const int l = mi / 5, kind = mi % 5;
        const float* src; bf16_t* dst; int K, N, mode = 0;
        if (kind == 0)      { K = DM;  N = NIN; src = p.in[2]  + (size_t)l * K * N; dst = (bf16_t*)(p.ws + OFF_WIN)  + (size_t)l * NIN * DM; }
        else if (kind == 1) { K = DM;  N = DM;  src = p.in[7]  + (size_t)l * K * N; dst = (bf16_t*)(p.ws + OFF_WOUT) + (size_t)l * DM * DM; }
        else if (kind == 2) { K = DM;  N = DFF; src = p.in[10] + (size_t)l * K * N; dst = (bf16_t*)(p.ws + OFF_WGU)  + (size_t)l * NGU * DM; mode = 1; }
        else if (kind == 3) { K = DM;  N = DFF; src = p.in[11] + (size_t)l * K * N; dst = (bf16_t*)(p.ws + OFF_WGU)  + (size_t)l * NGU * DM; mode = 2; }
        else                { K = DFF; N = DM;  src = p.in[12] + (size_t)l * K * N; dst = (bf16_t*)(p.ws + OFF_WD)   + (size_t)l * DM * DFF; }
        const int nkt = K / 64, nst = nkt * (N / 256), G = (int)gridDim.x;
        int t = pg8::obid(); bool have = t < nst;
        f32x4 v[8];
        if (have) { const int k0 = (t % nkt) * 64, n0 = (t / nkt) * 256;
#pragma unroll
            for (int h = 0; h < 8; ++h) { const int idx = tid + 512 * h; v[h] = *(const f32x4*)(src + (size_t)(k0 + (idx >> 6)) * N + n0 + (idx & 63) * 4); } }
        while (have) {
            const int k0 = (t % nkt) * 64, n0 = (t / nkt) * 256;
#pragma unroll
            for (int h = 0; h < 8; ++h) { const int idx = tid + 512 * h; LAS float* d = tile + (idx >> 6) * 257 + (idx & 63) * 4; d[0] = v[h][0]; d[1] = v[h][1]; d[2] = v[h][2]; d[3] = v[h][3]; }
            __syncthreads();
            const int tn = t + G; const bool have_n = tn < nst;
            if (have_n) { const int k1 = (tn % nkt) * 64, n1 = (tn / nkt) * 256;
#pragma unroll
                for (int h = 0; h < 8; ++h) { const int idx = tid + 512 * h; v[h] = *(const f32x4*)(src + (size_t)(k1 + (idx >> 6)) * N + n1 + (idx & 63) * 4); } }
#pragma unroll
            for (int h = 0; h < 4; ++h) { const int idx = tid + 512 * h, nl = idx >> 3, k8 = (idx & 7) * 8, n = n0 + nl;
                const int drow = mode == 0 ? n : ((n >> 7) * 256 + (n & 127) + (mode == 2 ? 128 : 0));
                float f[8];
#pragma unroll
                for (int e = 0; e < 8; ++e) f[e] = tile[(k8 + e) * 257 + nl];
                u32x4 w; w.x = cvt_pk_bf16(f[0], f[1]); w.y = cvt_pk_bf16(f[2], f[3]); w.z = cvt_pk_bf16(f[4], f[5]); w.w = cvt_pk_bf16(f[6], f[7]);
                *(u32x4*)(dst + (size_t)drow * K + k0 + k8) = w; }
            __syncthreads();
            t = tn; have = have_n;
        }
    }
}
__device__ __forceinline__ void xin_phase(const Params& p) {
    bf16_t* xb = (bf16_t*)(p.ws + OFF_XB);
    const size_t n4 = (size_t)T * DM / 4, np4 = (size_t)TP * DM / 4;
    for (size_t i = (size_t)pg8::obid() * 512 + pg8::otid(); i < n4; i += (size_t)gridDim.x * 512) {
        const f32x4 v = i < np4 ? ((const f32x4*)p.in[0])[i] : ((const f32x4*)p.in[1])[i - np4];
        u32x2 w; w.x = cvt_pk_bf16(v[0], v[1]); w.y = cvt_pk_bf16(v[2], v[3]); ((u32x2*)xb)[i] = w;
    }
}

__device__ __forceinline__ void prep_phase(LAS unsigned char* lds, const Params& p, int layer) {
    bf16_t* proj = (bf16_t*)(p.ws + OFF_PROJ);
    const int tid = pg8::otid(), j = tid & 15; const int bid = pg8::obid();
    const float* gq = p.in[3] + layer * 128; const float* gk = p.in[4] + layer * 128;
    double invA[8], invB[8];
#pragma unroll
    for (int e = 0; e < 8; ++e) { invA[e] = exp2(-(double)(8 * (j & 1) + e) * (18.931568569324174 / 16.0)) * 0.15915494309189535;
                                  invB[e] = exp2(-(double)(8 * (j & 3) + e) * (13.287712379549449 / 32.0)) * 0.15915494309189535; }
    for (int v = (bid * 512 + tid) >> 4; v < T * 36; v += gridDim.x * 32) {
        const int tok = v / 36, hv = v - tok * 36; const bool isB = hv >= 16;
        const int col = isB ? 3072 + (hv - 16) * 128 : hv * 128;
        bf16_t* ptr = proj + (size_t)tok * NIN + col + j * 8;
        const u32x4 raw = *(const u32x4*)ptr;
        float x[8] = {bf_lo(raw.x), bf_hi(raw.x), bf_lo(raw.y), bf_hi(raw.y), bf_lo(raw.z), bf_hi(raw.z), bf_lo(raw.w), bf_hi(raw.w)};
        float ss = 0.f;
#pragma unroll
        for (int e = 0; e < 8; ++e) ss += x[e] * x[e];
        ss += __shfl_xor(ss, 1); ss += __shfl_xor(ss, 2); ss += __shfl_xor(ss, 4); ss += __shfl_xor(ss, 8);
        const float r = rsqrtf(ss * (1.0f / 128.0f) + 1e-6f);
        const float* gp = (hv - 16 < 16) ? gq : gk;
        const int t = tok < TP ? tok : ((tok - TP) & (SS - 1));
        const bool act = isB || j < 4;
        const bool first = isB ? !(j & 4) : !(j & 2);
        const int ib = isB ? 8 * (j & 3) : 8 * (j & 1);
        const int pos = isB ? (j < 8 ? (t >> 6) : (t & 63)) : t;
        const double lf = isB ? (13.287712379549449 / 32.0) : (18.931568569324174 / 16.0);
#pragma unroll
        for (int e = 0; e < 8; ++e) {
            if (isB) x[e] = x[e] * r * gp[j * 8 + e];
        }
        float o[8];
#pragma unroll
        for (int e = 0; e < 8; ++e) {
            const float pa = __shfl_xor(x[e], 2), pb = __shfl_xor(x[e], 4);
            const float pr = isB ? pb : pa;
            double rev = (double)pos * (isB ? invB[e] : invA[e]); rev -= floor(rev);
            const float fr = (float)rev;
            const float cs = __builtin_amdgcn_cosf(fr), sn = __builtin_amdgcn_sinf(fr);
            const float rot = first ? (x[e] * cs - pr * sn) : (x[e] * cs + pr * sn);
            o[e] = act ? rot : x[e];
        }
        u32x4 w; w.x = cvt_pk_bf16(o[0], o[1]); w.y = cvt_pk_bf16(o[2], o[3]); w.z = cvt_pk_bf16(o[4], o[5]); w.w = cvt_pk_bf16(o[6], o[7]);
        *(u32x4*)ptr = w;
    }
    bf16_t* vtg = (bf16_t*)(p.ws + OFF_VT);
    LAS bf16_t* vt = (LAS bf16_t*)lds;
    for (int tl = bid; tl < (T / 64) * 20; tl += gridDim.x) {
        const int tb = tl / 20, hh = tl - tb * 20;
        const int vcol = hh < 8 ? 2048 + hh * 128 : (hh < 12 ? 5632 + (hh - 8) * 128 : 8192 + (hh - 12) * 128);
#pragma unroll
        for (int h = 0; h < 2; ++h) { const int ch = tid + 512 * h, tokl = ch >> 4, part = ch & 15;
            const u32x4 raw = *(const u32x4*)(proj + (size_t)(tb * 64 + tokl) * NIN + vcol + part * 8);
            LAS unsigned* d = (LAS unsigned*)(vt + tokl * 130 + part * 8);
            d[0] = raw.x; d[1] = raw.y; d[2] = raw.z; d[3] = raw.w; }
        __syncthreads();
#pragma unroll
        for (int h = 0; h < 2; ++h) { const int ch = tid + 512 * h, d = ch & 127, tp = ch >> 7;
            unsigned short s[8];
#pragma unroll
            for (int e = 0; e < 8; ++e) s[e] = vt[(tp * 8 + e) * 130 + d];
            u32x4 w; w.x = s[0] | ((unsigned)s[1] << 16); w.y = s[2] | ((unsigned)s[3] << 16); w.z = s[4] | ((unsigned)s[5] << 16); w.w = s[6] | ((unsigned)s[7] << 16);
            *(u32x4*)(vtg + (size_t)(hh * 128 + d) * T + tb * 64 + tp * 8) = w; }
        __syncthreads();
    }
}

__device__ __forceinline__ float rowmax4(float v) {
    const unsigned a = __float_as_uint(v); const auto r = __builtin_amdgcn_permlane16_swap(a, a, false, false);
    const float m = fmaxf(__uint_as_float(r[0]), __uint_as_float(r[1]));
    const unsigned b = __float_as_uint(m); const auto q = __builtin_amdgcn_permlane32_swap(b, b, false, false);
    return fmaxf(__uint_as_float(q[0]), __uint_as_float(q[1])); }
__device__ __forceinline__ float rowsum4(float v) {
    const unsigned a = __float_as_uint(v); const auto r = __builtin_amdgcn_permlane16_swap(a, a, false, false);
    const float m = __uint_as_float(r[0]) + __uint_as_float(r[1]);
    const unsigned b = __float_as_uint(m); const auto q = __builtin_amdgcn_permlane32_swap(b, b, false, false);
    return __uint_as_float(q[0]) + __uint_as_float(q[1]); }
template <int MODE, int QT>
__device__ __forceinline__ void attn_item(LAS unsigned char* lds, const bf16_t* proj, const bf16_t* vtg, bf16_t* mixed, const float* rpb,
                                          int tok0, int bstart, int s, int head) {
    const int tid = pg8::otid(), w = tid >> 6, lane = tid & 63, c = lane & 15, g = lane >> 4;
    const int t0 = tok0 - bstart;
    int qcol, kcol, vhead, mcol, kb_lo, kb_hi, kbase;
    if (MODE == 0) { qcol = head * 128; kcol = 1024 + head * 128; vhead = head; mcol = head * 128; kbase = t0 - 1024;
        kb_lo = t0 >= 1024 ? 0 : (1024 - t0) >> 6; const int hi = (s - kbase) >> 6; kb_hi = hi < 36 ? hi : 36; }
    else if (MODE == 1) { qcol = 3072 + head * 128; kcol = 5120 + (head >> 2) * 128; vhead = 8 + (head >> 2); mcol = 1024 + head * 128; kbase = 0; kb_lo = 0; kb_hi = s >> 6; }
    else { qcol = 6144 + head * 128; kcol = 7168 + head * 128; vhead = 12 + head; mcol = 3072 + head * 128;
        const int rows = s >> 6, i0 = t0 >> 6; int rlo = i0 - 4; rlo = rlo < 0 ? 0 : (rlo > rows - 8 ? rows - 8 : rlo); int r1 = i0 - 3; r1 = r1 < 0 ? 0 : (r1 > rows - 8 ? rows - 8 : r1);
        kbase = rlo * 64; kb_lo = 0; kb_hi = r1 + 8 - rlo; }
    bf16x8 qf[QT][4];
#pragma unroll
    for (int qt = 0; qt < QT; ++qt)
#pragma unroll
        for (int ks = 0; ks < 4; ++ks) qf[qt][ks] = *(const bf16x8*)(proj + (size_t)(tok0 + (w * QT + qt) * 16 + c) * NIN + qcol + ks * 32 + g * 8);
    f32x4 oacc[QT][8]; float mrun[QT], lsum[QT];
#pragma unroll
    for (int qt = 0; qt < QT; ++qt) { mrun[qt] = -1e30f; lsum[qt] = 0.f;
#pragma unroll
        for (int dg = 0; dg < 8; ++dg) oacc[qt][dg] = (f32x4){0.f, 0.f, 0.f, 0.f}; }
    const int kkey = tid >> 4, kpart = tid & 15;
    const int vd = tid >> 3, vpart = tid & 7;
    const bf16_t* kg0 = proj + (long)(bstart + kbase + kkey) * NIN + kcol + kpart * 8;
    const bf16_t* vg0 = vtg + (long)(vhead * 128 + vd) * T + (long)(bstart + kbase + vpart * 8);
    u32x4 rk0, rk1, rv0, rv1;
#define MK_LOADREGS(kbx) do { const long ko_ = (long)(kbx) * 64 * NIN, vo_ = (long)(kbx) * 64; rk0 = *(const u32x4*)(kg0 + ko_); rk1 = *(const u32x4*)(kg0 + ko_ + (long)32 * NIN); \
        rv0 = *(const u32x4*)(vg0 + vo_); rv1 = *(const u32x4*)(vg0 + vo_ + (long)64 * T); } while (0)
#define MK_WRITEREGS(b) do { LAS unsigned char* Kw = lds + (b) * 35840; LAS unsigned char* Vw = Kw + 17408; \
        *(LAS u32x4*)(Kw + (kkey * 136 + kpart * 8) * 2) = rk0; *(LAS u32x4*)(Kw + ((kkey + 32) * 136 + kpart * 8) * 2) = rk1; \
        { const int vpos = (vpart >> 2) * 32 + (vpart & 1) * 16 + ((vpart & 3) >> 1) * 4; \
          LAS unsigned char* v0 = Vw + (vd * 72 + vpos) * 2; LAS unsigned char* v1 = Vw + ((vd + 64) * 72 + vpos) * 2; \
          u32x2 t_; t_.x = rv0.x; t_.y = rv0.y; *(LAS u32x2*)v0 = t_; t_.x = rv0.z; t_.y = rv0.w; *(LAS u32x2*)(v0 + 16) = t_; \
          t_.x = rv1.x; t_.y = rv1.y; *(LAS u32x2*)v1 = t_; t_.x = rv1.z; t_.y = rv1.w; *(LAS u32x2*)(v1 + 16) = t_; } } while (0)
    __syncthreads();
    u32x4 sk0, sk1, sv0, sv1;
    MK_LOADREGS(kb_lo);
    MK_WRITEREGS(0);
    if (kb_lo + 2 < kb_hi) MK_LOADREGS(kb_lo + 2);
    if (kb_lo + 1 < kb_hi) { const long ko_ = (long)(kb_lo + 1) * 64 * NIN, vo_ = (long)(kb_lo + 1) * 64; sk0 = *(const u32x4*)(kg0 + ko_); sk1 = *(const u32x4*)(kg0 + ko_ + (long)32 * NIN);
        sv0 = *(const u32x4*)(vg0 + vo_); sv1 = *(const u32x4*)(vg0 + vo_ + (long)64 * T); }
#define MK_PV(stg) do { const LAS unsigned char* vb = lds + (stg) * 35840 + 17408 + (c * 72 + g * 8) * 2; \
          bf16x8 vf0[8], vf1[8]; \
          _Pragma("unroll") for (int dg = 0; dg < 8; ++dg) vf0[dg] = *(const LAS bf16x8*)(vb + (dg * 16 * 72) * 2); \
          _Pragma("unroll") for (int dg = 0; dg < 8; ++dg) vf1[dg] = *(const LAS bf16x8*)(vb + (dg * 16 * 72 + 32) * 2); \
          _Pragma("unroll") for (int dg = 0; dg < 8; ++dg) _Pragma("unroll") for (int qt = 0; qt < QT; ++qt) oacc[qt][dg] = __builtin_amdgcn_mfma_f32_16x16x32_bf16(vf0[dg], pf[qt][0], oacc[qt][dg], 0, 0, 0); \
          _Pragma("unroll") for (int dg = 0; dg < 8; ++dg) _Pragma("unroll") for (int qt = 0; qt < QT; ++qt) oacc[qt][dg] = __builtin_amdgcn_mfma_f32_16x16x32_bf16(vf1[dg], pf[qt][1], oacc[qt][dg], 0, 0, 0); } while (0)
    const int gp = __builtin_amdgcn_readfirstlane(w) >> 2;
    bf16x8 pf[QT][2];
    int cur = 0, prv = 0;
    auto body = [&](int kb, u32x4& rk0, u32x4& rk1, u32x4& rv0, u32x4& rv1) __attribute__((always_inline)) {
        const int nxt = cur == 2 ? 0 : cur + 1;
        __syncthreads();
        if (kb + 1 < kb_hi) MK_WRITEREGS(nxt);
        if (kb + 3 < kb_hi) MK_LOADREGS(kb + 3);
        const LAS unsigned char* Ks = lds + cur * 35840;
        f32x4 sacc[QT][4];
#pragma unroll
        for (int qt = 0; qt < QT; ++qt)
#pragma unroll
            for (int kg = 0; kg < 4; ++kg) sacc[qt][kg] = (f32x4){0.f, 0.f, 0.f, 0.f};
        { const LAS unsigned char* kb_ = Ks + (c * 136 + g * 8) * 2;
          bf16x8 kf[4][4];
#pragma unroll
          for (int ks = 0; ks < 4; ++ks)
#pragma unroll
              for (int kg = 0; kg < 4; ++kg) kf[ks][kg] = *(const LAS bf16x8*)(kb_ + (kg * 16 * 136 + ks * 32) * 2);
#pragma unroll
          for (int ks = 0; ks < 4; ++ks)
#pragma unroll
              for (int kg = 0; kg < 4; ++kg)
#pragma unroll
                  for (int qt = 0; qt < QT; ++qt) sacc[qt][kg] = __builtin_amdgcn_mfma_f32_16x16x32_bf16(kf[ks][kg], qf[qt][ks], sacc[qt][kg], 0, 0, 0); }
#pragma unroll
        for (int qt = 0; qt < QT; ++qt) {
            const int qi = (w * QT + qt) * 16 + c;
            float pv[4][4];
            if constexpr (MODE == 1) {
                const f32x4 m4 = __builtin_elementwise_max(__builtin_elementwise_max(sacc[qt][0], sacc[qt][1]), __builtin_elementwise_max(sacc[qt][2], sacc[qt][3]));
                float mx = fmaxf(fmaxf(m4[0], m4[1]), fmaxf(m4[2], m4[3])) * SC2;
                mx = rowmax4(mx);
                const float mnew = fmaxf(mrun[qt], mx), alpha = __builtin_amdgcn_exp2f(mrun[qt] - mnew); mrun[qt] = mnew;
                f32x4 ps4 = (f32x4){0.f, 0.f, 0.f, 0.f};
#pragma unroll
                for (int kg = 0; kg < 4; ++kg) { const f32x4 tt = sacc[qt][kg] * SC2 - mnew;
                    f32x4 pe; pe[0] = __builtin_amdgcn_exp2f(tt[0]); pe[1] = __builtin_amdgcn_exp2f(tt[1]); pe[2] = __builtin_amdgcn_exp2f(tt[2]); pe[3] = __builtin_amdgcn_exp2f(tt[3]);
                    ps4 += pe; pv[kg][0] = pe[0]; pv[kg][1] = pe[1]; pv[kg][2] = pe[2]; pv[kg][3] = pe[3]; }
                lsum[qt] = lsum[qt] * alpha + ((ps4[0] + ps4[1]) + (ps4[2] + ps4[3]));
#pragma unroll
                for (int dg = 0; dg < 8; ++dg) oacc[qt][dg] *= alpha;
            } else {
            float x[4][4]; bool ok[4][4]; float mx = -1e30f;
#pragma unroll
            for (int kg = 0; kg < 4; ++kg)
#pragma unroll
                for (int e = 0; e < 4; ++e) { const int jk = kg * 16 + g * 4 + e; float v = sacc[qt][kg][e] * SC2; bool valid = true;
                    if (MODE == 0) { const int dl = 64 * kb + jk - qi - 1024, ad = dl < 0 ? -dl : dl;
                        const int mult = (ad <= 64 ? 1 : 0) + (((dl & 3) == 0 && ad <= 256) ? 1 : 0) + (((dl & 15) == 0 && ad <= 1024) ? 1 : 0);
                        valid = mult > 0; v += mult == 3 ? 1.5849625007211562f : (mult == 2 ? 1.0f : 0.0f); }
                    if (MODE == 2) { const int rows = s >> 6, ri = (t0 >> 6) + (qi >> 6), qc = qi & 63, rk = (kbase >> 6) + kb;
                        int rs = ri - 4; rs = rs < 0 ? 0 : (rs > rows - 8 ? rows - 8 : rs); int cst = qc - 8; cst = cst < 0 ? 0 : (cst > 48 ? 48 : cst);
                        valid = rk >= rs && rk < rs + 8 && jk >= cst && jk < cst + 16;
                        if (valid) v += rpb[head * 465 + (rk - ri + 7) * 31 + (jk - qc + 15)] * 1.4426950408889634f; }
                    x[kg][e] = v; ok[kg][e] = valid; mx = valid ? fmaxf(mx, v) : mx; }
            mx = rowmax4(mx);
            const float mnew = fmaxf(mrun[qt], mx), alpha = __builtin_amdgcn_exp2f(mrun[qt] - mnew); mrun[qt] = mnew; lsum[qt] *= alpha;
#pragma unroll
            for (int dg = 0; dg < 8; ++dg) oacc[qt][dg] *= alpha;
            float ps = 0.f;
#pragma unroll
            for (int kg = 0; kg < 4; ++kg)
#pragma unroll
                for (int e = 0; e < 4; ++e) { const float pe = ok[kg][e] ? __builtin_amdgcn_exp2f(x[kg][e] - mnew) : 0.f; pv[kg][e] = pe; ps += pe; }
            lsum[qt] += ps;
            }
#pragma unroll
            for (int sI = 0; sI < 2; ++sI) { u32x4 pw; pw.x = cvt_pk_bf16(pv[2 * sI][0], pv[2 * sI][1]); pw.y = cvt_pk_bf16(pv[2 * sI][2], pv[2 * sI][3]);
                pw.z = cvt_pk_bf16(pv[2 * sI + 1][0], pv[2 * sI + 1][1]); pw.w = cvt_pk_bf16(pv[2 * sI + 1][2], pv[2 * sI + 1][3]);
                pf[qt][sI] = __builtin_bit_cast(bf16x8, pw); }
        }
        MK_PV(cur);
        prv = cur; cur = nxt;
    };
    for (int kb = kb_lo; kb < kb_hi; kb += 2) { body(kb, sk0, sk1, sv0, sv1); if (kb + 1 < kb_hi) body(kb + 1, rk0, rk1, rv0, rv1); }
#undef MK_PV
#undef MK_LOADREGS
#undef MK_WRITEREGS
#pragma unroll
    for (int qt = 0; qt < QT; ++qt) {
        const float l = rowsum4(lsum[qt]);
        const float inv = 1.0f / l;
        bf16_t* op = mixed + (size_t)(tok0 + (w * QT + qt) * 16 + c) * DM + mcol + g * 4;
#pragma unroll
        for (int dg = 0; dg < 8; ++dg) { const f32x4 o = oacc[qt][dg] * inv; u32x2 ow; ow.x = cvt_pk_bf16(o[0], o[1]); ow.y = cvt_pk_bf16(o[2], o[3]); *(u32x2*)(op + dg * 16) = ow; }
    }
}

__device__ __forceinline__ void attn_phase(LAS unsigned char* lds, const Params& p, int layer) {
    const bf16_t* proj = (const bf16_t*)(p.ws + OFF_PROJ); const bf16_t* vtg = (const bf16_t*)(p.ws + OFF_VT); bf16_t* mixed = (bf16_t*)(p.ws + OFF_MIX);
    const float* rpb = p.in[5] + layer * (8 * 15 * 31);
    for (int it = pg8::obid(); it < 1024; it += gridDim.x) { const int head = it & 15, qb = it >> 4; attn_item<1, 2>(lds, proj, vtg, mixed, rpb, qb * 256, 0, TP, head); }
    for (int it = pg8::obid(); it < 512; it += gridDim.x) { const int head = it & 15, qb = it >> 4; attn_item<1, 2>(lds, proj, vtg, mixed, rpb, TP + qb * 256, TP + (qb >> 3) * SS, SS, head); }
    for (int it = pg8::obid(); it < 1536; it += gridDim.x) { const int head = it & 7, tok0 = (it >> 3) * 128; const bool pr = tok0 < TP; const int bs = pr ? 0 : TP + ((tok0 - TP) / SS) * SS;
        attn_item<0, 1>(lds, proj, vtg, mixed, rpb, tok0, bs, pr ? TP : SS, head); }
    for (int it = pg8::obid(); it < 1536; it += gridDim.x) { const int head = it & 7, tok0 = (it >> 3) * 128; const bool pr = tok0 < TP; const int bs = pr ? 0 : TP + ((tok0 - TP) / SS) * SS;
        attn_item<2, 1>(lds, proj, vtg, mixed, rpb, tok0, bs, pr ? TP : SS, head); }
}

__device__ __forceinline__ void grms_phase(const Params& p, int layer) {
    bf16_t* mixed = (bf16_t*)(p.ws + OFF_MIX); const float* gg = p.in[6] + layer * DM;
    const int tid0 = pg8::otid(), lane = tid0 & 63, wv = tid0 >> 6; const int bid = pg8::obid();
    for (int tok = bid * 8 + wv; tok < T; tok += gridDim.x * 8) {
        bf16_t* row = mixed + (size_t)tok * DM;
        u32x4 raw[8]; float ssq[3] = {0.f, 0.f, 0.f};
#pragma unroll
        for (int k = 0; k < 8; ++k) { raw[k] = *(const u32x4*)(row + (lane + 64 * k) * 8);
            const float a0 = bf_lo(raw[k].x), a1 = bf_hi(raw[k].x), a2 = bf_lo(raw[k].y), a3 = bf_hi(raw[k].y), a4 = bf_lo(raw[k].z), a5 = bf_hi(raw[k].z), a6 = bf_lo(raw[k].w), a7 = bf_hi(raw[k].w);
            const float q = a0 * a0 + a1 * a1 + a2 * a2 + a3 * a3 + a4 * a4 + a5 * a5 + a6 * a6 + a7 * a7;
            ssq[k < 2 ? 0 : (k < 6 ? 1 : 2)] += q; }
        float sc[3];
#pragma unroll
        for (int gI = 0; gI < 3; ++gI) { float v = ssq[gI];
#pragma unroll
            for (int o = 32; o >= 1; o >>= 1) v += __shfl_xor(v, o);
            sc[gI] = rsqrtf(v / (gI == 1 ? 2048.0f : 1024.0f) + 1e-6f); }
#pragma unroll
        for (int k = 0; k < 8; ++k) { const float r = sc[k < 2 ? 0 : (k < 6 ? 1 : 2)]; const int col = (lane + 64 * k) * 8;
            const f32x4 g0 = *(const f32x4*)(gg + col), g1 = *(const f32x4*)(gg + col + 4);
            u32x4 w; w.x = cvt_pk_bf16(bf_lo(raw[k].x) * r * g0[0], bf_hi(raw[k].x) * r * g0[1]); w.y = cvt_pk_bf16(bf_lo(raw[k].y) * r * g0[2], bf_hi(raw[k].y) * r * g0[3]);
            w.z = cvt_pk_bf16(bf_lo(raw[k].z) * r * g1[0], bf_hi(raw[k].z) * r * g1[1]); w.w = cvt_pk_bf16(bf_lo(raw[k].w) * r * g1[2], bf_hi(raw[k].w) * r * g1[3]);
            *(u32x4*)(row + col) = w; }
    }
}
__device__ __forceinline__ void ln_phase(const Params& p, const float* gam, const float* bet) {
    bf16_t* xb = (bf16_t*)(p.ws + OFF_XB);
    const int tid0 = pg8::otid(), lane = tid0 & 63, wv = tid0 >> 6; const int bid = pg8::obid();
    for (int tok = bid * 8 + wv; tok < T; tok += gridDim.x * 8) {
        float* row = p.out + (size_t)tok * DM;
        f32x4 v[16]; float s = 0.f;
#pragma unroll
        for (int k = 0; k < 16; ++k) { v[k] = *(const f32x4*)(row + (lane + 64 * k) * 4); s += (v[k][0] + v[k][1]) + (v[k][2] + v[k][3]); }
#pragma unroll
        for (int o = 32; o >= 1; o >>= 1) s += __shfl_xor(s, o);
        const float mean = s * (1.0f / DM); float q = 0.f;
#pragma unroll
        for (int k = 0; k < 16; ++k) { const f32x4 d = v[k] - mean; q += (d[0] * d[0] + d[1] * d[1]) + (d[2] * d[2] + d[3] * d[3]); }
#pragma unroll
        for (int o = 32; o >= 1; o >>= 1) q += __shfl_xor(q, o);
        const float rstd = rsqrtf(q * (1.0f / DM) + 1e-5f);
#pragma unroll
        for (int k = 0; k < 16; ++k) { const int col = (lane + 64 * k) * 4; const f32x4 gv = *(const f32x4*)(gam + col), bv = *(const f32x4*)(bet + col);
            const f32x4 o = (v[k] - mean) * rstd * gv + bv; *(f32x4*)(row + col) = o;
            u32x2 w; w.x = cvt_pk_bf16(o[0], o[1]); w.y = cvt_pk_bf16(o[2], o[3]); *(u32x2*)(xb + (size_t)tok * DM + col) = w; }
    }
}

__global__ __launch_bounds__(512, 2) void fwd(Params p) {
    extern __shared__ __attribute__((aligned(16))) unsigned char shm[];
    LAS unsigned char* lds = (LAS unsigned char*)shm;
    volatile LAS unsigned* xbw = (volatile LAS unsigned*)(lds + pg8::STAGE_BYTES);
    if (threadIdx.x < 4) xbw[threadIdx.x] = 0u;
    __syncthreads();
    XcdBarrier bar = xcd_barrier_post((unsigned*)(p.ws + OFF_BAR), xbw);
    const int G = (int)gridDim.x;
    wt_phase(lds, p);
    xin_phase(p);
    xcd_barrier(bar);
    bf16_t* xb = (bf16_t*)(p.ws + OFF_XB); bf16_t* proj = (bf16_t*)(p.ws + OFF_PROJ); bf16_t* mixed = (bf16_t*)(p.ws + OFF_MIX); bf16_t* hdn = (bf16_t*)(p.ws + OFF_HDN);
#pragma unroll 1
    for (int l = 0; l < 2; ++l) {
        { pg8::Gemm g{xb, (const bf16_t*)(p.ws + OFF_WIN) + (size_t)l * NIN * DM, T, NIN, DM}; pg8::StaticOrder S; S.init(T, NIN, G, pg8::obid());
          pg8::EpiBf16<0> E{proj, NIN, nullptr, 0, 0}; pg8::gemm_phase<pg8::EpiBf16<0>, pg8::StaticOrder, false>(lds, g, S, E, nullptr); }
        xcd_barrier(bar);
        prep_phase(lds, p, l);
        xcd_barrier(bar);
        attn_phase(lds, p, l);
        xcd_barrier(bar);
        grms_phase(p, l);
        xcd_barrier(bar);
        { pg8::Gemm g{mixed, (const bf16_t*)(p.ws + OFF_WOUT) + (size_t)l * DM * DM, T, DM, DM}; pg8::StaticOrder S; S.init(T, DM, G, pg8::obid());
          EpiResid E{p.out, DM, l == 0 ? p.in[0] : p.out, l == 0 ? p.in[1] - (size_t)TP * DM : p.out}; pg8::gemm_phase<EpiResid, pg8::StaticOrder, false>(lds, g, S, E, nullptr); }
        xcd_barrier(bar);
        ln_phase(p, p.in[8] + l * DM, p.in[9] + l * DM);
        xcd_barrier(bar);
        { pg8::Gemm g{xb, (const bf16_t*)(p.ws + OFF_WGU) + (size_t)l * NGU * DM, T, NGU, DM}; pg8::StaticOrder S; S.init(T, NGU, G, pg8::obid());
          EpiSwiglu E{hdn, DFF}; pg8::gemm_phase<EpiSwiglu, pg8::StaticOrder, false>(lds, g, S, E, nullptr); }
        xcd_barrier(bar);
        { pg8::Gemm g{hdn, (const bf16_t*)(p.ws + OFF_WD) + (size_t)l * DM * DFF, T, DM, DFF}; pg8::StaticOrder S; S.init(T, DM, G, pg8::obid());
          EpiResid E{p.out, DM, p.out, p.out}; pg8::gemm_phase<EpiResid, pg8::StaticOrder, false>(lds, g, S, E, nullptr); }
        xcd_barrier(bar);
        ln_phase(p, p.in[13] + l * DM, p.in[14] + l * DM);
        xcd_barrier(bar);
    }
}
}

extern "C" void kernel_launch(void* const* d_in, const int* in_sizes, int n_in, void* d_out, int out_size, void* d_ws, size_t ws_size, hipStream_t stream) {
    constexpr int LDSB = pg8::STAGE_BYTES + 16;
    static int grid = 0;
    if (!grid) {
        int dev = 0, cus = 0, per_cu = 0;
        hipGetDevice(&dev);
        hipDeviceGetAttribute(&cus, hipDeviceAttributeMultiprocessorCount, dev);
        if (hipFuncSetAttribute((const void*)mk::fwd, hipFuncAttributeMaxDynamicSharedMemorySize, LDSB) != hipSuccess) { fprintf(stderr, "hipFuncSetAttribute failed\n"); grid = -1; }
        else if (hipOccupancyMaxActiveBlocksPerMultiprocessor(&per_cu, (const void*)mk::fwd, 512, LDSB) != hipSuccess || per_cu < 1) { fprintf(stderr, "occupancy query failed\n"); grid = -1; }
        else grid = cus;
    }
    if (grid <= 0 || ws_size < mk::WS_NEED || n_in < 15) { fprintf(stderr, "kernel_launch: refused (grid %d, ws %zu need %zu)\n", grid, ws_size, (size_t)mk::WS_NEED); return; }
    hipMemsetAsync((unsigned char*)d_ws + mk::OFF_BAR, 0, 16384, stream);
    mk::Params p{};
    for (int i = 0; i < 15; ++i) p.in[i] = (const float*)d_in[i];
    p.out = (float*)d_out; p.ws = (unsigned char*)d_ws;
    hipLaunchKernelGGL(mk::fwd, dim3(grid), dim3(512), LDSB, stream, p);
}
```
